# Optimizing an MI355X kernel written in HIP

```python
import jax, jax.numpy as jnp
from jax import lax
import numpy as np

D_MODEL = 1024
BATCH = 8
SEQ = 4096
DEPTH = 1

HEAD_DIM = 64
N_HEADS = D_MODEL // HEAD_DIM
N_HEADS_A = N_HEADS // 2
N_HEADS_B = N_HEADS - N_HEADS_A
DILATED_CONFIGS = ((128, 1), (512, 4), (2048, 16))
BLOCK = 128
KV_RANK = D_MODEL // 8
IDX_HEADS = 8
IDX_DIM = 64
IDX_SCALE = (IDX_HEADS * IDX_DIM) ** -0.5
TOPK_MAX = 256
D_FF = -(-8 * D_MODEL // (3 * 256)) * 256
EPS = 1e-6
SPLITS = (N_HEADS_A * HEAD_DIM, N_HEADS_A * HEAD_DIM, N_HEADS_A * HEAD_DIM,
          N_HEADS_B * HEAD_DIM, KV_RANK,
          IDX_HEADS * IDX_DIM, IDX_DIM, IDX_HEADS)
D_IN = sum(SPLITS)

kernel_name = "hybrid_dilated_swa_dsa_block"


def rmsnorm(x, g):
    xf = x.astype(jnp.float32)
    y = xf * lax.rsqrt(jnp.mean(xf * xf, axis=-1, keepdims=True) + EPS)
    return (y * g.astype(jnp.float32)).astype(x.dtype)


def alibi_slopes():
    s = 2.0 ** (-8.0 * (np.arange(N_HEADS, dtype=np.float32) + 1.0) / N_HEADS)
    return jnp.asarray(s[0::2], jnp.float32), jnp.asarray(s[1::2], jnp.float32)


def dilated_branch(q, k, v, window, dilation, slopes):
    bsz, seq, nh, hd = q.shape
    n = seq // dilation
    nb = -(-n // BLOCK)
    n_pad = nb * BLOCK
    w_res = window // dilation
    assert w_res <= BLOCK
    g = bsz * dilation

    def to_res(a):
        a = a.reshape(bsz, n, dilation, nh, hd).transpose(0, 2, 3, 1, 4).reshape(g, nh, n, hd)
        return jnp.pad(a, ((0, 0), (0, 0), (0, n_pad - n), (0, 0)))

    qr, kr, vr = to_res(q), to_res(k), to_res(v)

    def band(a):
        cur = a.reshape(g, nh, nb, BLOCK, hd)
        prev = jnp.pad(a, ((0, 0), (0, 0), (BLOCK, 0), (0, 0)))[:, :, :n_pad].reshape(g, nh, nb, BLOCK, hd)
        return jnp.concatenate([prev, cur], axis=3)

    kb, vb = band(kr), band(vr)
    qb = qr.reshape(g, nh, nb, BLOCK, hd)
    s = jnp.einsum('ghnqd,ghnkd->ghnqk', qb, kb).astype(jnp.float32) * (hd ** -0.5)
    dist = np.arange(BLOCK)[:, None] - np.arange(2 * BLOCK)[None, :] + BLOCK
    key_pos = np.arange(nb)[:, None] * BLOCK - BLOCK + np.arange(2 * BLOCK)[None, :]
    mask = ((dist >= 0) & (dist <= w_res))[None] & (key_pos >= 0)[:, None, :]
    bias = -slopes[:, None, None] * jnp.asarray(dist * dilation, jnp.float32)[None]
    s = jnp.where(mask[None, None], s + bias[None, :, None], -jnp.inf)
    m = jnp.max(s, axis=-1, keepdims=True)
    p = jnp.exp(s - m)
    l = jnp.sum(p, axis=-1, keepdims=True)
    o = jnp.einsum('ghnqk,ghnkd->ghnqd', (p / l).astype(v.dtype), vb)
    lse = (m + jnp.log(l))[..., 0]
    o = o.reshape(g, nh, n_pad, hd)[:, :, :n].reshape(bsz, dilation, nh, n, hd)
    o = o.transpose(0, 3, 1, 2, 4).reshape(bsz, seq, nh, hd)
    lse = lse.reshape(g, nh, n_pad)[:, :, :n].reshape(bsz, dilation, nh, n)
    lse = lse.transpose(0, 3, 1, 2).reshape(bsz, seq, nh)
    return o, lse


def dilated_mixture(q, k, v, slopes):
    outs, lses = [], []
    for window, dilation in DILATED_CONFIGS:
        o, lse = dilated_branch(q, k, v, window, dilation, slopes)
        outs.append(o.astype(jnp.float32))
        lses.append(lse)
    alpha = jax.nn.softmax(jnp.stack(lses, 0), axis=0)
    out = jnp.sum(alpha[..., None] * jnp.stack(outs, 0), axis=0)
    return out.astype(q.dtype)


def sparse_attention(q_idx, k_idx, w_idx, q_lat, c_kv, slopes):
    bsz, seq = c_kv.shape[0], c_kv.shape[1]
    nb = seq // BLOCK
    topk = min(TOPK_MAX, seq // 4)
    s_pos = jnp.arange(seq)
    k_idx_f = k_idx.astype(jnp.float32)

    def block_fn(i):
        start = i * BLOCK
        qi = lax.dynamic_slice_in_dim(q_idx, start, BLOCK, axis=1).astype(jnp.float32)
        wi = lax.dynamic_slice_in_dim(w_idx, start, BLOCK, axis=1).astype(jnp.float32)
        ql = lax.dynamic_slice_in_dim(q_lat, start, BLOCK, axis=1)
        t_pos = start + jnp.arange(BLOCK)
        logits = jnp.einsum('bqhd,bkd->bqhk', qi, k_idx_f)
        score = jnp.einsum('bqh,bqhk->bqk', wi, jax.nn.relu(logits))
        score = jnp.where(s_pos[None, None, :] <= t_pos[None, :, None], score, -jnp.inf)
        _, idx = lax.top_k(score, topk)
        c_sel = jax.vmap(lambda cb, ib: cb[ib])(c_kv, idx)
        s = jnp.einsum('bqhr,bqkr->bhqk', ql, c_sel).astype(jnp.float32) * (HEAD_DIM ** -0.5)
        dist = (t_pos[None, :, None] - idx).astype(jnp.float32)
        s = s - slopes[None, :, None, None] * dist[:, None]
        s = jnp.where((idx <= t_pos[None, :, None])[:, None], s, -jnp.inf)
        p = jax.nn.softmax(s, axis=-1)
        return jnp.einsum('bhqk,bqkr->bqhr', p.astype(c_sel.dtype), c_sel)

    o = lax.map(block_fn, jnp.arange(nb))
    return o.transpose(1, 0, 2, 3, 4).reshape(bsz, seq, o.shape[3], o.shape[4])


def setup_inputs(seed: int = 0) -> dict:
    key = jax.random.key(seed)
    ks = jax.random.split(key, 16)
    f32 = jnp.float32
    nrm = lambda k, shape, scale: jax.random.normal(k, shape, f32) * scale
    return {
        "x": nrm(ks[0], (BATCH, SEQ, D_MODEL), 1.0),
        "c": nrm(ks[1], (BATCH, D_MODEL), 1.0),
        "w_ada": nrm(ks[2], (DEPTH, D_MODEL, 6 * D_MODEL), 0.5 * D_MODEL ** -0.5),
        "b_ada": nrm(ks[3], (DEPTH, 6 * D_MODEL), 0.01),
        "g_attn": 1.0 + nrm(ks[4], (DEPTH, D_MODEL), 0.02),
        "w_in": nrm(ks[5], (DEPTH, D_MODEL, D_IN), D_MODEL ** -0.5),
        "kv_norm_g": 1.0 + nrm(ks[6], (DEPTH, KV_RANK), 0.02),
        "w_uk": nrm(ks[7], (DEPTH, N_HEADS_B, HEAD_DIM, KV_RANK), HEAD_DIM ** -0.5),
        "w_uv": nrm(ks[8], (DEPTH, N_HEADS_B, KV_RANK, HEAD_DIM), KV_RANK ** -0.5),
        "w_out": nrm(ks[9], (DEPTH, D_MODEL, D_MODEL), D_MODEL ** -0.5),
        "g_ffn": 1.0 + nrm(ks[10], (DEPTH, D_MODEL), 0.02),
        "w_gu": nrm(ks[11], (DEPTH, D_MODEL, 2 * D_FF), D_MODEL ** -0.5),
        "w_down": nrm(ks[12], (DEPTH, D_FF, D_MODEL), D_FF ** -0.5),
        "g_final": 1.0 + nrm(ks[13], (D_MODEL,), 0.02),
    }


def reference(x, c, w_ada, b_ada, g_attn, w_in, kv_norm_g, w_uk, w_uv, w_out, g_ffn, w_gu, w_down, g_final):
    bsz, seq, _ = x.shape
    slopes_a, slopes_b = alibi_slopes()
    offsets = [int(o) for o in np.cumsum(SPLITS)[:-1]]
    c_act = jax.nn.silu(c)
    for l in range(DEPTH):
        mod = c_act @ w_ada[l] + b_ada[l]
        sh1, sc1, ga1, sh2, sc2, ga2 = [m[:, None, :] for m in jnp.split(mod, 6, axis=-1)]

        h = rmsnorm(x, g_attn[l]) * (1.0 + sc1) + sh1
        proj = h @ w_in[l]
        qa, ka, va, qb, ckv, qi, ki, wi = jnp.split(proj, offsets, axis=-1)
        shp_a = (bsz, seq, N_HEADS_A, HEAD_DIM)
        out_a = dilated_mixture(qa.reshape(shp_a), ka.reshape(shp_a), va.reshape(shp_a), slopes_a)
        ckv = rmsnorm(ckv, kv_norm_g[l])
        q_lat = jnp.einsum('bthd,hdr->bthr', qb.reshape(bsz, seq, N_HEADS_B, HEAD_DIM), w_uk[l])
        o_lat = sparse_attention(qi.reshape(bsz, seq, IDX_HEADS, IDX_DIM), ki, wi * IDX_SCALE,
                                 q_lat, ckv, slopes_b)
        out_b = jnp.einsum('bthr,hrd->bthd', o_lat, w_uv[l])
        mixed = jnp.concatenate([out_a.reshape(bsz, seq, -1), out_b.reshape(bsz, seq, -1)], axis=-1)
        x = x + ga1 * (mixed @ w_out[l])

        h2 = rmsnorm(x, g_ffn[l]) * (1.0 + sc2) + sh2
        gate, up = jnp.split(h2 @ w_gu[l], 2, axis=-1)
        x = x + ga2 * ((jax.nn.silu(gate) * up) @ w_down[l])
    return rmsnorm(x, g_final)
```

```cpp
#include <hip/hip_runtime.h>
#include <cstdio>
#include <cstdint>
namespace pg8 {
#define PG8_LAS __attribute__((address_space(3)))
typedef unsigned short bf16_t;
typedef short bf16x8 __attribute__((ext_vector_type(8)));
typedef float f32x4 __attribute__((ext_vector_type(4)));
typedef unsigned u32x4 __attribute__((ext_vector_type(4)));
constexpr int BM = 256, BK = 64, HALF = 128, HTB = HALF * BK * 2  , STAGE_BYTES = 8 * HTB, NXCD = 8, WGM = 8;

__host__ __device__ __forceinline__ int lds_byte(int r, int c) { const int st = (r >> 4) * 2 + (c >> 5), rr = r & 15, cc = c & 31, ob = rr * 64 + cc * 2; return st * 1024 + (ob ^ (((ob >> 9) & 1) << 5)); }
__host__ __device__ __forceinline__ void stage_rc(int b, int& R, int& C) { const int st = b / 1024, sb = b % 1024, swz = sb ^ (((sb >> 9) & 1) << 5); R = (st >> 1) * 16 + swz / 64; C = (st & 1) * 32 + (swz % 64) / 2; }
__host__ __device__ __forceinline__ int perm32(int rho) { const int n = rho >> 4, i = rho & 15; return 8 * (i >> 2) + 4 * n + (i & 3); }

struct Unit { int pm, pn; };
struct Gemm { const bf16_t* A; const bf16_t* Bt; int M, N, K; };

struct StaticOrder {
    int nM, nN, nwg, G, c;
    __host__ __device__ void init(int M, int N, int G_, int c_) { nM = M / BM; nN = N / BM; nwg = nM * nN; G = G_; c = c_; }
    __host__ __device__ bool next(int i, Unit& u) const {
        const long L = (long)i * G + c; if (L >= nwg) return false;
        int wgid = (int)L; { const int q = nwg / NXCD, r = nwg % NXCD, xcd = wgid % NXCD, off = wgid / NXCD; wgid = (xcd < r ? xcd * (q + 1) : r * (q + 1) + (xcd - r) * q) + off; }
        const int nig = WGM * nN, gid = wgid / nig, fm = gid * WGM, gsz = (nM - fm) < WGM ? (nM - fm) : WGM;
        u.pm = fm + ((wgid % nig) % gsz); u.pn = (wgid % nig) / gsz; return true;
    }
    __device__ __forceinline__ void a_ready(const Unit&) const {}
    __device__ __forceinline__ void done(const Unit&) const {}
};

__device__ __forceinline__ unsigned cvt_pk_bf16(float lo, float hi) { unsigned r; asm volatile("v_cvt_pk_bf16_f32 %0, %1, %2" : "=v"(r) : "v"(lo), "v"(hi)); return r; }
typedef float f32x2 __attribute__((ext_vector_type(2)));
__device__ __forceinline__ f32x2 gelu_pk(f32x2 v) {
    const f32x2 av = __builtin_elementwise_abs(v), d = av * 0.2316418882f + 1.0f;
    f32x2 t; t.x = __builtin_amdgcn_rcpf(d.x); t.y = __builtin_amdgcn_rcpf(d.y);
    f32x2 q = t * 0.5307027145f + (-0.7265760135f); q = q * t + 0.7107068705f; q = q * t + (-0.142248368f); q = q * t + 0.127414796f; q = q * t;
    const f32x2 s = (v * v) * (-0.72134752044f);
    f32x2 e; e.x = __builtin_amdgcn_exp2f(s.x); e.y = __builtin_amdgcn_exp2f(s.y);
    const f32x2 m = v * (q * e), r = v - m;
    f32x2 o; o.x = v.x < 0.f ? m.x : r.x; o.y = v.y < 0.f ? m.y : r.y; return o;
}

template <int ACT  > struct EpiBf16 {
    static constexpr bool PERM = true, AFTER_DRAIN = false; static_assert(ACT == 0 || ACT == 1, "EpiBf16: ACT is 0 (none) or 1 (gelu_pk)");
    bf16_t* O; int ldc; const float* bias; int split_cols; size_t split_stride; float scale0;
    __device__ __forceinline__ void operator()(const f32x4 (&acc)[2][2][4][2], const Unit& u, int wr, int wc, int fr, int fq) const {
        const int row0 = u.pm * BM + wr * 64 + fr; int colt = u.pn * BM; bf16_t* base = O;
        float sc = 1.f; if (split_cols) { const int t = colt / split_cols; base += (size_t)t * split_stride; colt -= t * split_cols; if (t == 0) sc = scale0; }
        const int col0 = colt + wc * 32 + 8 * fq, bcol0 = u.pn * BM + wc * 32 + 8 * fq;
        f32x4 bv[2][2];
#pragma unroll
        for (int bj = 0; bj < 2; ++bj)
#pragma unroll
            for (int n = 0; n < 2; ++n) bv[bj][n] = bias ? *(const f32x4*)(bias + bcol0 + bj * HALF + 4 * n) : (f32x4){0.f, 0.f, 0.f, 0.f};
#pragma unroll
        for (int ai = 0; ai < 2; ++ai)
#pragma unroll
            for (int m = 0; m < 4; ++m) { bf16_t* rowp = base + (size_t)(row0 + ai * HALF + m * 16) * ldc + col0;
#pragma unroll
                for (int bj = 0; bj < 2; ++bj) { f32x4 v0 = acc[ai][bj][m][0] + bv[bj][0], v1 = acc[ai][bj][m][1] + bv[bj][1];
                    if (ACT == 1) { f32x2 a = gelu_pk((f32x2){v0[0], v0[1]}), b = gelu_pk((f32x2){v0[2], v0[3]}), c = gelu_pk((f32x2){v1[0], v1[1]}), d = gelu_pk((f32x2){v1[2], v1[3]});
                        v0 = (f32x4){a.x, a.y, b.x, b.y}; v1 = (f32x4){c.x, c.y, d.x, d.y}; }
                    v0 = v0 * sc; v1 = v1 * sc; u32x4 w; w.x = cvt_pk_bf16(v0[0], v0[1]); w.y = cvt_pk_bf16(v0[2], v0[3]); w.z = cvt_pk_bf16(v1[0], v1[1]); w.w = cvt_pk_bf16(v1[2], v1[3]);
                    *(u32x4*)(rowp + bj * HALF) = w; } }
    }
};
struct EpiGateRes {
    static constexpr bool PERM = false, AFTER_DRAIN = false;
    const float* base; float* out; int ldc; const float* gate; int gate_stride;
    __device__ __forceinline__ void operator()(const f32x4 (&acc)[2][2][4][2], const Unit& u, int wr, int wc, int fr, int fq) const {
        const int row0 = u.pm * BM + wr * 64 + fr, col0 = u.pn * BM + wc * 32 + 4 * fq;
        const float* g = gate + (size_t)((u.pm * BM) >> 12) * gate_stride + col0;
        f32x4 gv[2][2];
#pragma unroll
        for (int bj = 0; bj < 2; ++bj)
#pragma unroll
            for (int n = 0; n < 2; ++n) gv[bj][n] = *(const f32x4*)(g + bj * HALF + n * 16);
#pragma unroll
        for (int ai = 0; ai < 2; ++ai)
#pragma unroll
            for (int m = 0; m < 4; ++m) { const size_t off = (size_t)(row0 + ai * HALF + m * 16) * ldc + col0;
#pragma unroll
                for (int bj = 0; bj < 2; ++bj)
#pragma unroll
                    for (int n = 0; n < 2; ++n) { const f32x4 bs = *(const f32x4*)(base + off + bj * HALF + n * 16); const f32x4 o = bs + gv[bj][n] * acc[ai][bj][m][n]; *(f32x4*)(out + off + bj * HALF + n * 16) = o; }
                if (m & 1) asm volatile("" ::: "memory"); }
    }
};
struct EpiSwiGLU {
    static constexpr bool PERM = true, AFTER_DRAIN = false;
    bf16_t* O; int ldc;
    __device__ __forceinline__ static float silu_mul(float g, float u) { return g * __builtin_amdgcn_rcpf(1.0f + __builtin_amdgcn_exp2f(g * -1.4426950408889634f)) * u; }
    __device__ __forceinline__ void operator()(const f32x4 (&acc)[2][2][4][2], const Unit& u, int wr, int wc, int fr, int fq) const {
        const int row0 = u.pm * BM + wr * 64 + fr, col0 = u.pn * HALF + wc * 32 + 8 * fq;
#pragma unroll
        for (int ai = 0; ai < 2; ++ai)
#pragma unroll
            for (int m = 0; m < 4; ++m) { bf16_t* rowp = O + (size_t)(row0 + ai * HALF + m * 16) * ldc + col0;
                const f32x4 g0 = acc[ai][0][m][0], g1 = acc[ai][0][m][1], u0 = acc[ai][1][m][0], u1 = acc[ai][1][m][1];
                u32x4 w; w.x = cvt_pk_bf16(silu_mul(g0[0], u0[0]), silu_mul(g0[1], u0[1])); w.y = cvt_pk_bf16(silu_mul(g0[2], u0[2]), silu_mul(g0[3], u0[3]));
                w.z = cvt_pk_bf16(silu_mul(g1[0], u1[0]), silu_mul(g1[1], u1[1])); w.w = cvt_pk_bf16(silu_mul(g1[2], u1[2]), silu_mul(g1[3], u1[3]));
                *(u32x4*)rowp = w; }
    }
};
template <class Epi, class Sched, bool ALIGN_EPI = false, bool SP2 = false>
__device__ __forceinline__ void gemm_phase(PG8_LAS unsigned char* lds, const Gemm g, const Sched& S, const Epi& E) {
    const int tid = threadIdx.x, wid = __builtin_amdgcn_readfirstlane(tid >> 6), lane = tid & 63, wr = wid >> 2, wc = wid & 3, fr = lane & 15, fq = lane >> 4;
    const int K = g.K, nt = K / BK;
    unsigned voffA[2], voffB[2];
#pragma unroll
    for (int i = 0; i < 2; ++i) { int R, C; stage_rc(tid * 16 + i * 8192, R, C); const int Rb = Epi::PERM ? ((R & ~31) + perm32(R & 31)) : R;
        voffA[i] = (unsigned)(R * K + C) * 2u; voffB[i] = (unsigned)(Rb * K + C) * 2u; }
    const size_t kstep = (size_t)(BK * 2);
    const size_t hstep = (size_t)HALF * K * 2;
    const size_t tstep = 2 * hstep;
    const unsigned ldsw = (unsigned)wid * 1024u;
    const int aoff = lds_byte(wr * 64 + fr, fq * 8), boff = lds_byte(wc * 32 + fr, fq * 8);
#define PG8_SA(b, h) (((b) * 2 + (h)) * HTB)
#define PG8_SB(b, h) ((4 + (b) * 2 + (h)) * HTB)
#define PG8_STAGE(bufoff, gbase, voff) do { _Pragma("unroll") for (int _i = 0; _i < 2; ++_i) \
        __builtin_amdgcn_global_load_lds((const unsigned*)((const char*)(gbase) + (voff)[_i]), (PG8_LAS unsigned*)(lds + (bufoff) + ldsw + _i * 8192), 16, 0, 0); } while (0)
#define PG8_LDA(dst, b, h) do { _Pragma("unroll") for (int m = 0; m < 4; ++m) _Pragma("unroll") for (int k = 0; k < 2; ++k) dst[m][k] = *(const PG8_LAS bf16x8*)(lds + PG8_SA(b, h) + aoff + m * 2048 + k * 1024); } while (0)
#define PG8_LDB(dst, b, h) do { _Pragma("unroll") for (int n = 0; n < 2; ++n) _Pragma("unroll") for (int k = 0; k < 2; ++k) dst[n][k] = *(const PG8_LAS bf16x8*)(lds + PG8_SB(b, h) + boff + n * 2048 + k * 1024); } while (0)
#define PG8_MMA(ai, bj, At, Bt) do { __builtin_amdgcn_s_setprio(1); _Pragma("unroll") for (int m = 0; m < 4; ++m) _Pragma("unroll") for (int n = 0; n < 2; ++n) _Pragma("unroll") for (int k = 0; k < 2; ++k) \
        acc[ai][bj][m][n] = __builtin_amdgcn_mfma_f32_16x16x32_bf16(Bt[n][k], At[m][k], acc[ai][bj][m][n], 0, 0, 0); __builtin_amdgcn_s_setprio(0); } while (0)
#define PG8_WAIT_V(n) asm volatile("s_waitcnt vmcnt(" #n ")" ::: "memory")
#define PG8_WAIT_L(n) asm volatile("s_waitcnt lgkmcnt(" #n ")" ::: "memory")
#define PG8_BAR __builtin_amdgcn_s_barrier()
#define PG8_SCHED __builtin_amdgcn_sched_barrier(0)
    Unit cur, nxt; int ui = 0;
    if (!S.next(0, cur)) return;
    f32x4 acc[2][2][4][2];
#pragma unroll
    for (int a = 0; a < 2; ++a)
#pragma unroll
        for (int b = 0; b < 2; ++b)
#pragma unroll
            for (int m = 0; m < 4; ++m)
#pragma unroll
                for (int n = 0; n < 2; ++n) acc[a][b][m][n] = (f32x4){0.f, 0.f, 0.f, 0.f};
    bf16x8 At[4][2], B0[2][2], B1[2][2];
    const char* cA = (const char*)g.A + (size_t)cur.pm * tstep; const char* cB = (const char*)g.Bt + (size_t)cur.pn * tstep;
    S.a_ready(cur);
    if constexpr (SP2) {
        PG8_STAGE(PG8_SB(0, 0), cB, voffB); PG8_STAGE(PG8_SB(0, 1), cB + hstep, voffB); PG8_STAGE(PG8_SA(0, 0), cA, voffA); PG8_STAGE(PG8_SA(0, 1), cA + hstep, voffA);
        if (wr == 1) PG8_BAR;
        PG8_WAIT_V(2); PG8_BAR;
        PG8_STAGE(PG8_SB(1, 0), cB + kstep, voffB); PG8_STAGE(PG8_SA(1, 0), cA + kstep, voffA); PG8_STAGE(PG8_SB(1, 1), cB + hstep + kstep, voffB);
        PG8_WAIT_V(6); PG8_BAR;
    } else {
        PG8_STAGE(PG8_SB(0, 0), cB, voffB); PG8_STAGE(PG8_SA(0, 0), cA, voffA); PG8_STAGE(PG8_SB(0, 1), cB + hstep, voffB); PG8_STAGE(PG8_SA(0, 1), cA + hstep, voffA);
        if (wr == 1) PG8_BAR;
        PG8_WAIT_V(4); PG8_BAR;
        PG8_STAGE(PG8_SB(1, 0), cB + kstep, voffB); PG8_STAGE(PG8_SA(1, 0), cA + kstep, voffA); PG8_STAGE(PG8_SB(1, 1), cB + hstep + kstep, voffB);
        PG8_WAIT_V(6); PG8_BAR;
    }
    for (;;) {
        const bool has_next = S.next(ui + 1, nxt);
        const char* nA = has_next ? (const char*)g.A + (size_t)nxt.pm * tstep : cA; const char* nB = has_next ? (const char*)g.Bt + (size_t)nxt.pn * tstep : cB;
        for (int t = 0; t < nt; t += 2) {
            const bool last = (t == nt - 2);
            const char* a1 = cA + (size_t)(t + 1) * kstep;
            const char* a2 = last ? nA : cA + (size_t)(t + 2) * kstep; const char* b2 = last ? nB : cB + (size_t)(t + 2) * kstep;
            const char* a3 = a2 + kstep; const char* b3 = b2 + kstep;
            if (last && has_next) S.a_ready(nxt);
            if constexpr (SP2) {
            PG8_LDB(B0, 0, 0); PG8_LDB(B1, 0, 1); PG8_SCHED; PG8_LDA(At, 0, 0); PG8_STAGE(PG8_SA(1, 1), a1 + hstep, voffA);
            PG8_WAIT_V(8); PG8_WAIT_L(0); PG8_BAR; PG8_MMA(0, 0, At, B0); PG8_MMA(0, 1, At, B1); PG8_BAR; PG8_SCHED;
            PG8_LDA(At, 0, 1); PG8_STAGE(PG8_SB(0, 0), b2, voffB); PG8_STAGE(PG8_SB(0, 1), b2 + hstep, voffB); PG8_STAGE(PG8_SA(0, 0), a2, voffA);
            PG8_WAIT_V(8); PG8_WAIT_L(0); PG8_BAR; PG8_MMA(1, 0, At, B0); PG8_MMA(1, 1, At, B1); PG8_BAR; PG8_SCHED;
            PG8_LDB(B0, 1, 0); PG8_LDB(B1, 1, 1); PG8_SCHED; PG8_LDA(At, 1, 0); PG8_STAGE(PG8_SA(0, 1), a2 + hstep, voffA);
            PG8_WAIT_V(8); PG8_WAIT_L(0); PG8_BAR; PG8_MMA(0, 0, At, B0); PG8_MMA(0, 1, At, B1); PG8_BAR; PG8_SCHED;
            PG8_LDA(At, 1, 1); PG8_STAGE(PG8_SB(1, 0), b3, voffB); PG8_STAGE(PG8_SB(1, 1), b3 + hstep, voffB); PG8_STAGE(PG8_SA(1, 0), a3, voffA);
            PG8_WAIT_V(8); PG8_WAIT_L(0); PG8_BAR; PG8_MMA(1, 0, At, B0); PG8_MMA(1, 1, At, B1); PG8_BAR; PG8_SCHED;
            } else {
            PG8_LDB(B0, 0, 0); PG8_SCHED; PG8_LDA(At, 0, 0); PG8_STAGE(PG8_SA(1, 1), a1 + hstep, voffA);
            PG8_WAIT_L(8); PG8_BAR; PG8_WAIT_L(0); PG8_MMA(0, 0, At, B0); PG8_BAR; PG8_SCHED;
            PG8_LDB(B1, 0, 1); PG8_STAGE(PG8_SB(0, 0), b2, voffB);
            PG8_BAR; PG8_WAIT_L(0); PG8_MMA(0, 1, At, B1); PG8_BAR;
            PG8_LDA(At, 0, 1); PG8_STAGE(PG8_SA(0, 0), a2, voffA);
            PG8_BAR; PG8_WAIT_L(0); PG8_MMA(1, 0, At, B0); PG8_BAR; PG8_SCHED;
            PG8_STAGE(PG8_SB(0, 1), b2 + hstep, voffB);
            PG8_WAIT_V(6); PG8_BAR; PG8_MMA(1, 1, At, B1); PG8_BAR;
            PG8_LDB(B0, 1, 0); PG8_SCHED; PG8_LDA(At, 1, 0); PG8_STAGE(PG8_SA(0, 1), a2 + hstep, voffA);
            PG8_WAIT_L(8); PG8_BAR; PG8_WAIT_L(0); PG8_MMA(0, 0, At, B0); PG8_BAR; PG8_SCHED;
            PG8_LDB(B1, 1, 1); PG8_STAGE(PG8_SB(1, 0), b3, voffB);
            PG8_BAR; PG8_WAIT_L(0); PG8_MMA(0, 1, At, B1); PG8_BAR;
            PG8_LDA(At, 1, 1); PG8_STAGE(PG8_SA(1, 0), a3, voffA);
            PG8_BAR; PG8_WAIT_L(0); PG8_MMA(1, 0, At, B0); PG8_BAR; PG8_SCHED;
            PG8_STAGE(PG8_SB(1, 1), b3 + hstep, voffB);
            PG8_WAIT_V(6); PG8_BAR; PG8_MMA(1, 1, At, B1); PG8_BAR;
            }
        }
        if constexpr (ALIGN_EPI) { if (wr == 0) PG8_BAR; }
        if constexpr (!Epi::AFTER_DRAIN) { E(acc, cur, wr, wc, fr, fq); S.done(cur); }
        if (!has_next) break;
#pragma unroll
        for (int a = 0; a < 2; ++a)
#pragma unroll
            for (int b = 0; b < 2; ++b)
#pragma unroll
                for (int m = 0; m < 4; ++m)
#pragma unroll
                    for (int n = 0; n < 2; ++n) acc[a][b][m][n] = (f32x4){0.f, 0.f, 0.f, 0.f};
        cur = nxt; cA = nA; cB = nB; ++ui;
        if constexpr (ALIGN_EPI) { if (wr == 1) PG8_BAR; }
    }
    PG8_WAIT_V(0);
    if constexpr (!ALIGN_EPI) { if (wr == 0) PG8_BAR; }
    PG8_BAR;
    if constexpr (Epi::AFTER_DRAIN) { E.fused(acc, cur, wr, wc, fr, fq, lds, wid, lane); S.done(cur); }
#undef PG8_SA
#undef PG8_SB
#undef PG8_STAGE
#undef PG8_LDA
#undef PG8_LDB
#undef PG8_MMA
#undef PG8_WAIT_V
#undef PG8_WAIT_L
#undef PG8_BAR
#undef PG8_SCHED
}
}
constexpr int NWAVES = 8;
constexpr int BATCH = 8, T = 4096, D = 1024, M = BATCH * T;
constexpr int DIN = 2760;
constexpr int NPROJ = 3328;
constexpr int C_QA = 0, C_KA = 512, C_VA = 1024, C_QL = 1536, C_CKV = 2560, C_QI = 2688, C_KI = 3200, C_WI = 3264, C_END = 3272;
constexpr int KOUT = 1536;
constexpr int DFF = 2816, NGU = 2 * DFF;
constexpr int TOPK = 256, RLAT = 128;
constexpr float EPS = 1e-6f;
constexpr float LOG2E = 1.4426950408889634f;
constexpr float IDX_SCALE = 0.044194173824159216f;

constexpr size_t MiB = 1u << 20;
constexpr size_t WS_CTL = 0, CTL_ZERO_BYTES = 1 * MiB;
constexpr size_t WS_MOD = 1 * MiB;
constexpr size_t WS_WIN = 2 * MiB;
constexpr size_t WS_WOUT = 9 * MiB;
constexpr size_t WS_WGU = 12 * MiB;
constexpr size_t WS_WDN = 23 * MiB;
constexpr size_t WS_CKVN = 29 * MiB;
constexpr size_t WS_IDX = 37 * MiB;
constexpr size_t WS_XN = 54 * MiB;
constexpr size_t WS_MIX = 118 * MiB;
constexpr size_t WS_PROJ = 214 * MiB;
constexpr size_t WS_H = WS_PROJ;
constexpr size_t WS_END = 422 * MiB;
static_assert(WS_WIN + (size_t)NPROJ * D * 2 <= WS_WOUT && WS_WOUT + (size_t)D * KOUT * 2 <= WS_WGU && WS_WGU + (size_t)NGU * D * 2 <= WS_WDN && WS_WDN + (size_t)D * DFF * 2 <= WS_CKVN, "ws map 1");
static_assert(WS_CKVN + (size_t)M * 128 * 2 <= WS_IDX && WS_IDX + (size_t)M * 256 * 2 <= WS_XN && WS_XN + (size_t)M * D * 2 <= WS_MIX && WS_MIX + (size_t)M * KOUT * 2 <= WS_PROJ && WS_PROJ + (size_t)M * NPROJ * 2 <= WS_END, "ws map 2");
constexpr int CW_TMO = 0, CW_CODE = 1, CW_ERR = 2;
constexpr int CW_BAR = 4096;

constexpr int RING_OFF = 0, RING_BYTES = 131072;
constexpr int LDSCTL_OFF = RING_BYTES, MISC_OFF = LDSCTL_OFF + 320;
constexpr int EX_OFF = LDSCTL_OFF + 512, EX_BYTES = 8192;
constexpr int LDS_BYTES = EX_OFF + EX_BYTES;
#define GAS __attribute__((address_space(1)))
#define LAS __attribute__((address_space(3)))
typedef unsigned short bf16;
typedef unsigned v4u __attribute__((ext_vector_type(4)));
typedef float f32x4 __attribute__((ext_vector_type(4)));
typedef short bf16x8 __attribute__((ext_vector_type(8)));
typedef GAS unsigned gu32;
typedef GAS unsigned long long gu64;
#define RLX_AGENT __ATOMIC_RELAXED, __HIP_MEMORY_SCOPE_AGENT
#define LDS_WAIT() asm volatile("s_waitcnt lgkmcnt(0)" ::: "memory")
#define VM_WAIT() asm volatile("s_waitcnt vmcnt(0)" ::: "memory")
__device__ __forceinline__ unsigned long long rt() { return __builtin_amdgcn_s_memrealtime(); }
__device__ __forceinline__ unsigned f2bf(float f) { unsigned u = __builtin_bit_cast(unsigned, f); return (u + 0x7fffu + ((u >> 16) & 1u)) >> 16; }
__device__ __forceinline__ unsigned pk2(float lo, float hi) { return f2bf(lo) | (f2bf(hi) << 16); }
#define XB_TMO      128
#define XB_XCNT(j)  (256  + 64 * (j))
#define XB_XSUB(j)  (1280 + 64 * (j))
#define XB_XGEN(j)  (2304 + 64 * (j))
#define XB_TOP      3328
#define XB_TOPGEN   3392
#define XCD_BAR_WORDS 3456
#define XB_SPIN_CAP (1u << 18)

__device__ __forceinline__ unsigned xb_ld(unsigned* p)              { return __hip_atomic_load(p, __ATOMIC_RELAXED, __HIP_MEMORY_SCOPE_AGENT); }
__device__ __forceinline__ unsigned xb_add(unsigned* p, unsigned v) { return __hip_atomic_fetch_add(p, v, __ATOMIC_RELAXED, __HIP_MEMORY_SCOPE_AGENT); }
__device__ __forceinline__ unsigned xb_xcc_id() { return (unsigned)__builtin_amdgcn_s_getreg((3 << 11) | 20) & 0xFu; }
#define XB_SPIN(cond, bar) do { unsigned _sp = 0; while (cond) { __builtin_amdgcn_s_sleep(1); \
    if ((++_sp & 255u) == 0u) { if (xb_ld(&(bar)[XB_TMO])) break; if (_sp > XB_SPIN_CAP) { atomicAdd(&(bar)[XB_TMO], 1u); break; } } } } while (0)

struct XcdBarrier {
    unsigned* bar; unsigned x;
    volatile LAS unsigned* st;
};

__device__ __forceinline__ XcdBarrier xcd_barrier_post(unsigned* bar, volatile LAS unsigned* st) {
    XcdBarrier b; b.bar = bar; b.x = xb_xcc_id(); b.st = st;
    if (threadIdx.x == 0) (void)xb_add(&bar[XB_XCNT(b.x)], 1u);
    return b;
}
__device__ __forceinline__ void xcd_barrier_complete(unsigned* bar, unsigned x, unsigned& nloc, unsigned& nx) {
    const unsigned G = gridDim.x * gridDim.y * gridDim.z;
    unsigned sum, cnt, mine, sp = 0u;
    for (;;) {
        sum = 0u; cnt = 0u; mine = 0u;
#pragma unroll
        for (unsigned j = 0; j < 16; ++j) { const unsigned c = xb_ld(&bar[XB_XCNT(j)]); sum += c; cnt += (c > 0u) ? 1u : 0u; mine = (j == x) ? c : mine; }
        if (sum == G) break;
        __builtin_amdgcn_s_sleep(1);
        if ((++sp & 255u) == 0u) { if (xb_ld(&bar[XB_TMO])) break; if (sp > XB_SPIN_CAP) { atomicAdd(&bar[XB_TMO], 1u); break; } }
    }
    nloc = mine > 0u ? mine : 1u; nx = cnt > 0u ? cnt : 1u;
}

__device__ __forceinline__ void xcd_barrier(const XcdBarrier& b) {
    asm volatile("s_waitcnt vmcnt(0)" ::: "memory");
    __syncthreads();
    if (threadIdx.x == 0) {
        unsigned* bar = b.bar;
        __builtin_amdgcn_s_waitcnt(0);
        unsigned nloc = b.st[0], nx = b.st[1];
        if (nloc == 0u) { xcd_barrier_complete(bar, b.x, nloc, nx); b.st[0] = nloc; b.st[1] = nx; }
        const unsigned old = xb_add(&bar[XB_XSUB(b.x)], 1u);
        const unsigned gen = old / nloc;
        if (old + 1u == (gen + 1u) * nloc) {
            __builtin_amdgcn_fence(__ATOMIC_RELEASE, "agent");
            asm volatile("s_waitcnt vmcnt(0)" ::: "memory");
            const unsigned og = xb_add(&bar[XB_TOP], 1u);
            const unsigned tg = og / nx;
            if (og + 1u == (tg + 1u) * nx) xb_add(&bar[XB_TOPGEN], 1u);
            else XB_SPIN(xb_ld(&bar[XB_TOPGEN]) == tg, bar);
            __builtin_amdgcn_fence(__ATOMIC_ACQUIRE, "agent");
            xb_add(&bar[XB_XGEN(b.x)], 1u);
            asm volatile("s_waitcnt vmcnt(0)" ::: "memory");
        } else {
            XB_SPIN(xb_ld(&bar[XB_XGEN(b.x)]) == gen, bar);
            __builtin_amdgcn_fence(__ATOMIC_ACQUIRE, "agent");
            asm volatile("s_waitcnt vmcnt(0)" ::: "memory");
        }
    }
    __syncthreads();
}
typedef float f32x16 __attribute__((ext_vector_type(16)));
typedef short s16x4 __attribute__((ext_vector_type(4)));
typedef unsigned u32x2 __attribute__((ext_vector_type(2)));
typedef float f32x2_t __attribute__((ext_vector_type(2)));
typedef __bf16 bf16x2_t __attribute__((ext_vector_type(2)));
__device__ __forceinline__ unsigned pkbf(float lo, float hi) { f32x2_t v = {lo, hi}; bf16x2_t b = __builtin_convertvector(v, bf16x2_t); return __builtin_bit_cast(unsigned, b); }
__device__ __forceinline__ float bf2f(unsigned short h) { return __builtin_bit_cast(float, (unsigned)h << 16); }
__device__ __forceinline__ float bflo(unsigned w) { return __builtin_bit_cast(float, w << 16); }
__device__ __forceinline__ float bfhi(unsigned w) { return __builtin_bit_cast(float, w & 0xffff0000u); }
__device__ __forceinline__ float ex2(float x) { return __builtin_amdgcn_exp2f(x); }
__device__ __forceinline__ float swap32_max(float v) { auto rr = __builtin_amdgcn_permlane32_swap(__float_as_uint(v), __float_as_uint(v), false, false); return fmaxf(__uint_as_float(rr[0]), __uint_as_float(rr[1])); }
__device__ __forceinline__ float swap32_sum(float v) { auto rr = __builtin_amdgcn_permlane32_swap(__float_as_uint(v), __float_as_uint(v), false, false); return __uint_as_float(rr[0]) + __uint_as_float(rr[1]); }
typedef short v4i16_t __attribute__((ext_vector_type(4)));
__device__ __forceinline__ s16x4 tr16(LAS const unsigned char* p) { return __builtin_bit_cast(s16x4, __builtin_amdgcn_ds_read_tr16_b64_v4i16((LAS v4i16_t*)p)); }

struct Frame {
    LAS unsigned char* lds;
    volatile LAS unsigned* MISC;
    gu32* ctl;
    int tid, lane, wave;
    int G;
    const float *x, *c, *w_ada, *b_ada, *g_attn, *w_in, *kv_g, *w_uk, *w_uv, *w_out, *g_ffn, *w_gu, *w_down, *g_final;
    float* out;
    float* MOD;
    bf16 *WIN, *WOUT, *WGU, *WDN, *CKVN, *XN, *MIX, *PROJ, *HB;
    unsigned short* IDX;
};
__device__ __forceinline__ float wave_sum(float v) {
#pragma unroll
    for (int o = 1; o < 64; o <<= 1) v += __shfl_xor(v, o);
    return v;
}

__device__ __forceinline__ void tr_item(const float* W, int ldw, int k0, int n0, int nvalid, bf16* WT, int ldt, int drow0, LAS float* scr, int lane) {
#pragma unroll 8
    for (int i = 0; i < 32; ++i) { const int kk = 2 * i + (lane >> 5), nn = lane & 31; scr[kk * 33 + nn] = nn < nvalid ? W[(size_t)(k0 + kk) * ldw + n0 + nn] : 0.f; }
    LDS_WAIT(); asm volatile("" ::: "memory");
    const int c = lane & 7;
#pragma unroll
    for (int j = 0; j < 4; ++j) { const int n = (lane >> 3) + 8 * j; const LAS float* s = scr + (8 * c) * 33 + n;
        v4u o; o.x = pk2(s[0 * 33], s[1 * 33]); o.y = pk2(s[2 * 33], s[3 * 33]); o.z = pk2(s[4 * 33], s[5 * 33]); o.w = pk2(s[6 * 33], s[7 * 33]);
        if (n < nvalid) *(GAS v4u*)(WT + (size_t)(drow0 + n) * ldt + k0 + 8 * c) = o; }
    LDS_WAIT(); asm volatile("" ::: "memory");
}
__device__ __forceinline__ void p0_prologue(Frame& F) {
    LAS float* L = (LAS float*)(F.lds + RING_OFF);
    const int tid = F.tid, lane = F.lane, wave = F.wave;
    for (int it = blockIdx.x; it < 448; it += F.G) {
        if (it < 192) {
            LAS float* sc = L;
            LAS float* red = L + 8192;
            for (int e = tid; e < 8192; e += 512) { const float v = F.c[e]; sc[e] = v / (1.0f + __expf(-v)); }
            __syncthreads();
            const int j0 = 32 * it, col = lane & 31, ksub = lane >> 5;
            float acc[8];
#pragma unroll
            for (int b = 0; b < 8; ++b) acc[b] = 0.f;
            for (int i = 0; i < 64; ++i) { const int k = 128 * wave + 2 * i + ksub; const float wv = F.w_ada[(size_t)k * 6144 + j0 + col];
#pragma unroll
                for (int b = 0; b < 8; ++b) acc[b] += sc[b * 1024 + k] * wv; }
#pragma unroll
            for (int b = 0; b < 8; ++b) red[((wave * 2 + ksub) * 8 + b) * 32 + col] = acc[b];
            __syncthreads();
            if (tid < 256) { const int b = tid >> 5, cc = tid & 31; float s = F.b_ada[j0 + cc];
#pragma unroll
                for (int p = 0; p < 16; ++p) s += red[(p * 8 + b) * 32 + cc];
                F.MOD[b * 6144 + j0 + cc] = s; }
            __syncthreads();
        } else if (it < 320) {
            const int f = it - 192, h = f >> 4, k0 = 64 * (f & 15);
            LAS float* win_s = L;
            LAS float* wuk_s = L + 64 * 65;
            for (int e = tid; e < 4096; e += 512) { const int kk = e >> 6, d = e & 63; win_s[kk * 65 + d] = F.w_in[(size_t)(k0 + kk) * DIN + 1536 + h * 64 + d]; }
            for (int e = tid; e < 8192; e += 512) wuk_s[e] = F.w_uk[(size_t)h * 8192 + e];
            __syncthreads();
            const int kk = tid & 63, r0 = 16 * (tid >> 6);
            float acc[16];
#pragma unroll
            for (int i = 0; i < 16; ++i) acc[i] = 0.f;
            for (int d = 0; d < 64; ++d) { const float a = win_s[kk * 65 + d];
#pragma unroll
                for (int i = 0; i < 16; ++i) acc[i] += a * wuk_s[d * 128 + r0 + i]; }
#pragma unroll
            for (int i = 0; i < 16; ++i) F.WIN[(size_t)(C_QL + h * 128 + r0 + i) * D + k0 + kk] = (bf16)f2bf(acc[i]);
            __syncthreads();
        } else {
            const int f = it - 320, h = f >> 4, n0 = 64 * (f & 15);
            LAS float* wuv_s = L;
            LAS float* wo_s = L + 128 * 65;
            for (int e = tid; e < 8192; e += 512) { const int r = e >> 6, d = e & 63; wuv_s[r * 65 + d] = F.w_uv[(size_t)h * 8192 + e]; }
            for (int e = tid; e < 4096; e += 512) { const int d = e >> 6, nn = e & 63; wo_s[e] = F.w_out[(size_t)(512 + h * 64 + d) * D + n0 + nn]; }
            __syncthreads();
            const int r = tid & 127, nn0 = 16 * (tid >> 7);
            float acc[16];
#pragma unroll
            for (int i = 0; i < 16; ++i) acc[i] = 0.f;
            for (int d = 0; d < 64; ++d) { const float a = wuv_s[r * 65 + d];
#pragma unroll
                for (int i = 0; i < 16; ++i) acc[i] += a * wo_s[d * 64 + nn0 + i]; }
#pragma unroll
            for (int i = 0; i < 16; ++i) F.WOUT[(size_t)(n0 + nn0 + i) * KOUT + 512 + h * 128 + r] = (bf16)f2bf(acc[i]);
            __syncthreads();
        }
    }
    __syncthreads();
    LAS float* scr = (LAS float*)(F.lds + RING_OFF + wave * 16384);
    const int gw = blockIdx.x * NWAVES + wave, NGW = F.G * NWAVES;
    constexpr int J1 = 16 * 48, J2 = 16 * 23, J4 = 8 * 32, J5 = 16 * 176, J6 = 44 * 32;
    for (int it = gw; it < J1 + J2 + J4 + J5 + J6; it += NGW) {
        int r = it;
        if (r < J1) { const int kb = r / 48, nb = r % 48; tr_item(F.w_in, DIN, 64 * kb, 32 * nb, 32, F.WIN, D, 32 * nb, scr, lane); continue; } r -= J1;
        if (r < J2) { const int kb = r / 23, nb = r % 23; const int n0 = 2048 + 32 * nb; const int nv = (DIN - n0) < 32 ? (DIN - n0) : 32; tr_item(F.w_in, DIN, 64 * kb, n0, nv, F.WIN, D, n0 + 512, scr, lane); continue; } r -= J2;
        if (r < J4) { const int kb = r / 32, nb = r % 32; tr_item(F.w_out, D, 64 * kb, 32 * nb, 32, F.WOUT, KOUT, 32 * nb, scr, lane); continue; } r -= J4;
        if (r < J5) { const int kb = r / 176, nb = r % 176; const int n0 = 32 * nb; const int isup = n0 >= DFF ? 1 : 0; const int u0 = n0 - isup * DFF; const int drow = (u0 >> 7) * 256 + isup * 128 + (u0 & 127);
            tr_item(F.w_gu, NGU, 64 * kb, n0, 32, F.WGU, D, drow, scr, lane); continue; } r -= J5;
        { const int kb = r / 32, nb = r % 32; tr_item(F.w_down, D, 64 * kb, 32 * nb, 32, F.WDN, DFF, 32 * nb, scr, lane); }
    }
    { const int gt = blockIdx.x * 512 + tid; const int nchunk = (NPROJ - C_END) * D / 8;
      for (int e = gt; e < nchunk; e += F.G * 512) *(GAS v4u*)(F.WIN + (size_t)C_END * D + (size_t)e * 8) = (v4u){0u, 0u, 0u, 0u}; }
}

__device__ __forceinline__ void modnorm_rows(Frame& F, const float* X, const float* g, int sc_chunk, int sh_chunk, bf16* out) {
    const int gw = blockIdx.x * NWAVES + F.wave, NGW = F.G * NWAVES;
    for (int m = gw; m < M; m += NGW) {
        const int b = m >> 12;
        const GAS f32x4* xr = (const GAS f32x4*)(X + (size_t)m * D) + F.lane;
        const GAS f32x4* gr = (const GAS f32x4*)g + F.lane;
        const GAS f32x4* scr = (const GAS f32x4*)(F.MOD + b * 6144 + sc_chunk * 1024) + F.lane;
        const GAS f32x4* shr = (const GAS f32x4*)(F.MOD + b * 6144 + sh_chunk * 1024) + F.lane;
        f32x4 v[4]; float s = 0.f;
#pragma unroll
        for (int j = 0; j < 4; ++j) { v[j] = xr[64 * j]; s += (v[j].x * v[j].x + v[j].y * v[j].y) + (v[j].z * v[j].z + v[j].w * v[j].w); }
        const float rstd = 1.0f / sqrtf(wave_sum(s) * (1.f / D) + EPS);
        GAS unsigned long long* o8 = (GAS unsigned long long*)(out + (size_t)m * D) + F.lane;
#pragma unroll
        for (int j = 0; j < 4; ++j) { const f32x4 gg = gr[64 * j], sc = scr[64 * j], sh = shr[64 * j];
            const f32x4 y = v[j] * rstd * gg * (sc + 1.0f) + sh;
            o8[64 * j] = (unsigned long long)pkbf(y.x, y.y) | ((unsigned long long)pkbf(y.z, y.w) << 32); }
    }
}
__device__ __forceinline__ void final_norm_rows(Frame& F) {
    const int gw = blockIdx.x * NWAVES + F.wave, NGW = F.G * NWAVES;
    for (int m = gw; m < M; m += NGW) {
        GAS f32x4* xr = (GAS f32x4*)(F.out + (size_t)m * D) + F.lane;
        const GAS f32x4* gr = (const GAS f32x4*)F.g_final + F.lane;
        f32x4 v[4]; float s = 0.f;
#pragma unroll
        for (int j = 0; j < 4; ++j) { v[j] = xr[64 * j]; s += (v[j].x * v[j].x + v[j].y * v[j].y) + (v[j].z * v[j].z + v[j].w * v[j].w); }
        const float rstd = 1.0f / sqrtf(wave_sum(s) * (1.f / D) + EPS);
#pragma unroll
        for (int j = 0; j < 4; ++j) xr[64 * j] = v[j] * rstd * gr[64 * j];
    }
}
__device__ __forceinline__ void ckv_norm_rows(Frame& F) {
    const int gw = blockIdx.x * NWAVES + F.wave, NGW = F.G * NWAVES;
    const int sub = F.lane >> 4, c8 = (F.lane & 15) * 8;
    f32x4 g0 = *(const GAS f32x4*)(F.kv_g + c8), g1 = *(const GAS f32x4*)(F.kv_g + c8 + 4);
    for (int it = gw; it < M / 4; it += NGW) {
        const int m = 4 * it + sub;
        const v4u w = *(const GAS v4u*)(F.PROJ + (size_t)m * NPROJ + C_CKV + c8);
        float v[8] = {bflo(w.x), bfhi(w.x), bflo(w.y), bfhi(w.y), bflo(w.z), bfhi(w.z), bflo(w.w), bfhi(w.w)};
        float s = 0.f;
#pragma unroll
        for (int j = 0; j < 8; ++j) s += v[j] * v[j];
        s += __shfl_xor(s, 1); s += __shfl_xor(s, 2); s += __shfl_xor(s, 4); s += __shfl_xor(s, 8);
        const float rstd = 1.0f / sqrtf(s * (1.f / 128.f) + EPS);
        v4u o; o.x = pkbf(v[0] * rstd * g0.x, v[1] * rstd * g0.y); o.y = pkbf(v[2] * rstd * g0.z, v[3] * rstd * g0.w);
        o.z = pkbf(v[4] * rstd * g1.x, v[5] * rstd * g1.y); o.w = pkbf(v[6] * rstd * g1.z, v[7] * rstd * g1.w);
        *(GAS v4u*)(F.CKVN + (size_t)m * 128 + c8) = o;
    }
}
namespace ga {
constexpr int VROW = 192;
constexpr int VTILE = 32 * VROW;
__device__ __forceinline__ int crow(int reg, int hi) { return (reg & 3) + 8 * (reg >> 2) + 4 * hi; }
struct TileP { int d, g, tok0, jb; };
__device__ __forceinline__ TileP tile_params(int n, int T0, int r) {
    TileP p;
    if (n < 5) { p.d = 16; p.g = 1; p.tok0 = T0 + r + 16 * (-128 + 32 * n); p.jb = 128 - 32 * n; }
    else if (n < 13) { const int a = n - 5; p.d = 4; p.g = 4; p.tok0 = T0 + (r & 3) + 4 * ((r >> 2) - 128 + 32 * a); p.jb = 128 - 32 * a; }
    else { const int a = n - 13; p.d = 1; p.g = 16; p.tok0 = T0 + r - 128 + 32 * a; p.jb = 128 - 32 * a; }
    return p;
}
__device__ __forceinline__ void unit(int b, int h, int rng, const bf16* PROJ, bf16* MIX, LAS unsigned char* vt, int lane, int wave) {
    const int qi = lane & 31, hi = lane >> 5;
    const int T0 = rng * 512;
    const size_t rowbase = (size_t)b * T;
    const float slope = exp2f(-0.5f * (float)(2 * h + 1));
    const float sl2 = slope * LOG2E, c2 = 0.125f * LOG2E;
    const int blk = (lane >> 4) & 1, q4 = (lane & 15) >> 2, p4 = lane & 3;
    for (int rs = 0; rs < 2; ++rs) {
        const int r = 2 * wave + rs;
        const int tq = T0 + r + 16 * qi;
        bf16x8 qf[4];
#pragma unroll
        for (int s = 0; s < 4; ++s) qf[s] = *(const GAS bf16x8*)(PROJ + (rowbase + tq) * NPROJ + C_QA + h * 64 + 16 * s + 8 * hi);
        float mrun = -1e30f, lsum = 0.f;
        f32x16 o0 = {}, o1 = {};
        bf16x8 kn[4], vn[4];
        { const TileP p = tile_params(0, T0, r); int tok = p.tok0 + p.d * qi; tok = tok < 0 ? 0 : tok;
          const bf16* kp = PROJ + (rowbase + tok) * NPROJ + h * 64 + 8 * hi;
#pragma unroll
          for (int s = 0; s < 4; ++s) { kn[s] = *(const GAS bf16x8*)(kp + C_KA + 16 * s); vn[s] = *(const GAS bf16x8*)(kp + C_VA + 16 * s); } }
        for (int n = 0; n < 33; ++n) {
            const TileP p = tile_params(n, T0, r);
            bf16x8 kf[4], vf[4];
#pragma unroll
            for (int s = 0; s < 4; ++s) { kf[s] = kn[s]; vf[s] = vn[s]; }
            if (n + 1 < 33) { const TileP pn = tile_params(n + 1, T0, r); int tok = pn.tok0 + pn.d * qi; tok = tok < 0 ? 0 : tok;
                const bf16* kp = PROJ + (rowbase + tok) * NPROJ + h * 64 + 8 * hi;
#pragma unroll
                for (int s = 0; s < 4; ++s) { kn[s] = *(const GAS bf16x8*)(kp + C_KA + 16 * s); vn[s] = *(const GAS bf16x8*)(kp + C_VA + 16 * s); } }
            if (p.tok0 + p.d * 31 < 0) continue;
#pragma unroll
            for (int s = 0; s < 4; ++s) *(LAS bf16x8*)(vt + qi * VROW + 32 * s + 16 * hi) = vf[s];
            f32x16 sacc = {};
#pragma unroll
            for (int s = 0; s < 4; ++s) sacc = __builtin_amdgcn_mfma_f32_32x32x16_bf16(kf[s], qf[s], sacc, 0, 0, 0);
            const int jl = p.g * qi + p.jb - 4 * hi;
            const int mmin = (p.tok0 < 0) ? ((-p.tok0 + p.d - 1) / p.d) : 0;
            const float sd = sl2 * (float)p.d;
            float sv[16]; float mx = -1e30f;
#pragma unroll
            for (int reg = 0; reg < 16; ++reg) { const int mo = (reg & 3) + 8 * (reg >> 2); const int j = jl - mo; const bool ok = (j >= 0) && (j <= 128) && (mo + 4 * hi >= mmin);
                const float v = ok ? (sacc[reg] * c2 - sd * (float)j) : -1e30f; sv[reg] = v; mx = fmaxf(mx, v); }
            mx = swap32_max(mx);
            const float mnew = fmaxf(mrun, mx);
            const float alpha = ex2(mrun - mnew);
            mrun = mnew;
            float ps = 0.f; float pv[16];
#pragma unroll
            for (int reg = 0; reg < 16; ++reg) { const float pe = (sv[reg] > -1e29f) ? ex2(sv[reg] - mnew) : 0.f; pv[reg] = pe; ps += pe; }
            lsum = lsum * alpha + ps;
            o0 *= alpha; o1 *= alpha;
            v4u pb0, pb1;
            pb0.x = pkbf(pv[0], pv[1]); pb0.y = pkbf(pv[2], pv[3]); pb0.z = pkbf(pv[4], pv[5]); pb0.w = pkbf(pv[6], pv[7]);
            pb1.x = pkbf(pv[8], pv[9]); pb1.y = pkbf(pv[10], pv[11]); pb1.z = pkbf(pv[12], pv[13]); pb1.w = pkbf(pv[14], pv[15]);
            LDS_WAIT();
#pragma unroll
            for (int s = 0; s < 2; ++s) {
                const bf16x8 pb = __builtin_bit_cast(bf16x8, s == 0 ? pb0 : pb1);
#pragma unroll
                for (int mt = 0; mt < 2; ++mt) {
                    const LAS unsigned char* a0 = vt + (16 * s + 4 * hi + q4) * VROW + (32 * mt + 16 * blk + 4 * p4) * 2;
                    const s16x4 lo = tr16(a0), hi4 = tr16(a0 + 8 * VROW);
                    const bf16x8 va = {lo[0], lo[1], lo[2], lo[3], hi4[0], hi4[1], hi4[2], hi4[3]};
                    if (mt == 0) o0 = __builtin_amdgcn_mfma_f32_32x32x16_bf16(va, pb, o0, 0, 0, 0);
                    else o1 = __builtin_amdgcn_mfma_f32_32x32x16_bf16(va, pb, o1, 0, 0, 0);
                }
            }
            LDS_WAIT();
        }
        const float linv = 1.0f / swap32_sum(lsum);
        bf16* op = MIX + (rowbase + tq) * KOUT + h * 64 + 4 * hi;
#pragma unroll
        for (int mt = 0; mt < 2; ++mt)
#pragma unroll
            for (int gq = 0; gq < 4; ++gq) { const f32x16& o = mt == 0 ? o0 : o1;
                u32x2 w; w.x = pkbf(o[4 * gq] * linv, o[4 * gq + 1] * linv); w.y = pkbf(o[4 * gq + 2] * linv, o[4 * gq + 3] * linv);
                *(GAS u32x2*)(op + 32 * mt + 8 * gq) = w; }
    }
}
}
namespace tk {
constexpr int CAP = 1792;
constexpr int SEL_OFF = 0, CAND_OFF = 8192;
__device__ __forceinline__ unsigned mono(float sc) { const unsigned bits = __float_as_uint(sc); return bits ^ ((unsigned)((int)bits >> 31) | 0x80000000u); }

template <int PASS>
__device__ __forceinline__ void score_pass(const bf16* PROJ, size_t rowbase, int QT0, int nkt, LAS unsigned* HIST, LAS unsigned* EX, const bf16x8 (&qf)[4][4], int lane, int wave) {
    const int kc = lane & 31, hk = lane >> 5;
    int bst[4][2];
    if (PASS == 1) {
#pragma unroll
        for (int mt = 0; mt < 4; ++mt)
#pragma unroll
            for (int be = 0; be < 2; ++be) bst[mt][be] = (int)EX[4 * mt + 2 * hk + be];
    }
    LAS unsigned short* SEL = (LAS unsigned short*)((LAS unsigned char*)HIST + SEL_OFF);
    LAS unsigned* CAND = (LAS unsigned*)((LAS unsigned char*)HIST + CAND_OFF);
    bf16x8 kn[4];
    if (wave < nkt) { const bf16* kp = PROJ + (rowbase + 32 * wave + kc) * NPROJ + C_KI + 8 * hk;
#pragma unroll
        for (int s = 0; s < 4; ++s) kn[s] = *(const GAS bf16x8*)(kp + 16 * s); }
    for (int kt = wave; kt < nkt; kt += NWAVES) {
        bf16x8 kf[4];
#pragma unroll
        for (int s = 0; s < 4; ++s) kf[s] = kn[s];
        if (kt + NWAVES < nkt) { const bf16* kp = PROJ + (rowbase + 32 * (kt + NWAVES) + kc) * NPROJ + C_KI + 8 * hk;
#pragma unroll
            for (int s = 0; s < 4; ++s) kn[s] = *(const GAS bf16x8*)(kp + 16 * s); }
        const int key = 32 * kt + kc;
#pragma unroll
        for (int mt = 0; mt < 4; ++mt) {
            f32x16 X = {};
#pragma unroll
            for (int s = 0; s < 4; ++s) X = __builtin_amdgcn_mfma_f32_32x32x16_bf16(qf[mt][s], kf[s], X, 0, 0, 0);
#pragma unroll
            for (int be = 0; be < 2; ++be) {
                asm volatile("" ::: "memory");
                const LAS f32x4* wp = (const LAS f32x4*)(EX + 64 + 8 * (4 * mt + 2 * hk + be));
                const f32x4 wa = wp[0], wb = wp[1];
                float sc = wa[0] * fmaxf(X[8 * be + 0], 0.f);
                sc += wa[1] * fmaxf(X[8 * be + 1], 0.f); sc += wa[2] * fmaxf(X[8 * be + 2], 0.f); sc += wa[3] * fmaxf(X[8 * be + 3], 0.f);
                sc += wb[0] * fmaxf(X[8 * be + 4], 0.f); sc += wb[1] * fmaxf(X[8 * be + 5], 0.f); sc += wb[2] * fmaxf(X[8 * be + 6], 0.f); sc += wb[3] * fmaxf(X[8 * be + 7], 0.f);
                sc += 0.0f;
                const int qq = 4 * mt + 2 * hk + be;
                if (key <= QT0 + qq) {
                    const unsigned k32 = mono(sc); const int bin = (int)(k32 >> 20);
                    if (PASS == 0) {
                        __hip_atomic_fetch_add(HIST + qq * 2048 + (bin >> 1), 1u << (16 * (bin & 1)), __ATOMIC_RELAXED, __HIP_MEMORY_SCOPE_WORKGROUP);
                    } else {
                        if (bin > bst[mt][be]) { const unsigned pos = __hip_atomic_fetch_add(EX + 32 + qq, 1u, __ATOMIC_RELAXED, __HIP_MEMORY_SCOPE_WORKGROUP); if (pos < 256u) SEL[qq * 256 + pos] = (unsigned short)key; }
                        else if (bin == bst[mt][be]) { const unsigned pos = __hip_atomic_fetch_add(EX + 48 + qq, 1u, __ATOMIC_RELAXED, __HIP_MEMORY_SCOPE_WORKGROUP); if (pos < (unsigned)CAP) CAND[qq * CAP + pos] = ((k32 & 0xFFFFFu) << 12) | (unsigned)(4095 - key); }
                    }
                }
            }
        }
    }
}

__device__ __forceinline__ void unit(int b, int qt, const bf16* PROJ, unsigned short* IDX, LAS unsigned char* lds, LAS unsigned* EX, gu32* errw, int tid, int lane, int wave) {
    const int QT0 = 16 * qt;
    const size_t rowbase = (size_t)b * T;
    if (QT0 < TOPK) {
        const int qq = tid >> 5, j0 = (tid & 31) * 8, t = QT0 + qq;
        unsigned short v[8];
#pragma unroll
        for (int j = 0; j < 8; ++j) v[j] = (j0 + j <= t) ? (unsigned short)(j0 + j) : (unsigned short)0xFFFF;
        v4u w; w.x = v[0] | ((unsigned)v[1] << 16); w.y = v[2] | ((unsigned)v[3] << 16); w.z = v[4] | ((unsigned)v[5] << 16); w.w = v[6] | ((unsigned)v[7] << 16);
        *(GAS v4u*)(IDX + (rowbase + t) * 256 + j0) = w;
        return;
    }
    LAS unsigned* HIST = (LAS unsigned*)lds;
    const int nkt = (QT0 + 16 + 31) >> 5;
    bf16x8 qf[4][4];
    { const int rho = lane & 31, hk = lane >> 5; const int ql = (rho >> 4) + 2 * ((rho >> 2) & 1), hd = 4 * ((rho >> 3) & 1) + (rho & 3);
#pragma unroll
      for (int mt = 0; mt < 4; ++mt) { const bf16* qp = PROJ + (rowbase + QT0 + 4 * mt + ql) * NPROJ + C_QI + hd * 64 + 8 * hk;
#pragma unroll
          for (int s = 0; s < 4; ++s) qf[mt][s] = *(const GAS bf16x8*)(qp + 16 * s); } }
    if (tid < 128) { const int qq = tid >> 3, h = tid & 7; ((LAS float*)EX)[64 + tid] = bf2f(PROJ[(rowbase + QT0 + qq) * NPROJ + C_WI + h]) * IDX_SCALE; }
    for (int e = tid; e < 16 * 2048 / 4; e += 512) ((LAS v4u*)HIST)[e] = (v4u){0u, 0u, 0u, 0u};
    __syncthreads();
    score_pass<0>(PROJ, rowbase, QT0, nkt, HIST, EX, qf, lane, wave);
    __syncthreads();
#pragma unroll 1
    for (int qs = 0; qs < 2; ++qs) {
        const int qq = 2 * wave + qs;
        const LAS unsigned* Hq = HIST + qq * 2048;
        unsigned tot = 0;
        for (int i = 0; i < 32; ++i) { const unsigned w = Hq[32 * lane + ((i + lane) & 31)]; tot += (w & 0xFFFFu) + (w >> 16); }
        unsigned S = tot;
#pragma unroll
        for (int off = 1; off < 64; off <<= 1) { const unsigned v = __shfl_down(S, off); if (lane + off < 64) S += v; }
        const unsigned long long mk = __ballot(S >= (unsigned)TOPK);
        const int ls = mk ? (63 - __clzll(mk)) : 0;
        unsigned acc = __shfl(S, ls) - __shfl(tot, ls);
        int bstar = -1;
        for (int i = 31; i >= 0; --i) { const unsigned w = Hq[32 * ls + i]; const unsigned h16 = w >> 16, l16 = w & 0xFFFFu;
            if (bstar < 0) { if (acc + h16 >= (unsigned)TOPK) bstar = 64 * ls + 2 * i + 1; else acc += h16; }
            if (bstar < 0) { if (acc + l16 >= (unsigned)TOPK) bstar = 64 * ls + 2 * i; else acc += l16; } }
        if (lane == 0) { EX[qq] = (unsigned)bstar; EX[16 + qq] = acc; EX[32 + qq] = 0u; EX[48 + qq] = 0u; if (bstar < 0 || mk == 0ull) __hip_atomic_store(errw, 1u, RLX_AGENT); }
    }
    __syncthreads();
    score_pass<1>(PROJ, rowbase, QT0, nkt, HIST, EX, qf, lane, wave);
    __syncthreads();
    LAS unsigned short* SEL = (LAS unsigned short*)(lds + SEL_OFF);
    LAS unsigned* CAND = (LAS unsigned*)(lds + CAND_OFF);
#pragma unroll 1
    for (int qs = 0; qs < 2; ++qs) {
        const int qq = 2 * wave + qs;
        const unsigned na = EX[16 + qq], nsel = EX[32 + qq]; unsigned nc = EX[48 + qq];
        const unsigned need = (unsigned)TOPK - na;
        if (lane == 0 && (nsel != na || nc < need || nc > (unsigned)CAP)) __hip_atomic_store(errw, 2u, RLX_AGENT);
        nc = nc > (unsigned)CAP ? (unsigned)CAP : nc;
        for (unsigned i = lane; i < nc; i += 64) { const unsigned cv = CAND[qq * CAP + i]; unsigned rank = 0;
            for (unsigned j = 0; j < nc; ++j) rank += (CAND[qq * CAP + j] > cv) ? 1u : 0u;
            if (rank < need) SEL[qq * 256 + na + rank] = (unsigned short)(4095u - (cv & 0xFFFu)); }
        LDS_WAIT(); asm volatile("" ::: "memory");
        if (lane < 32) { const v4u w = *(const LAS v4u*)(SEL + qq * 256 + lane * 8); *(GAS v4u*)(IDX + (rowbase + QT0 + qq) * 256 + lane * 8) = w; }
    }
    __syncthreads();
}
}
namespace sp {
constexpr int IMG_BYTES = 8192, IDXL_BYTES = 512, WAVE_BYTES = IMG_BYTES + IDXL_BYTES;
__device__ __forceinline__ unsigned off_b(unsigned row, unsigned ch) { return 256u * row + 16u * (ch ^ (((row & 3u) << 2) | ((row >> 2) & 3u))); }
__device__ __forceinline__ void query(int m  , const bf16* PROJ, const bf16* CKVN, const unsigned short* IDX, bf16* MIX, LAS unsigned char* wl, int lane) {
    LAS unsigned char* img = wl; LAS unsigned short* idl = (LAS unsigned short*)(wl + IMG_BYTES);
    const int b = m >> 12, t = m & 4095;
    const int hd = lane & 15, g = lane >> 4;
    const bf16* cb = CKVN + (size_t)b * T * 128;
    { const u32x2 w = *(const GAS u32x2*)(IDX + (size_t)m * 256 + 4 * lane); *(LAS u32x2*)(idl + 4 * lane) = w; }
    bf16x8 qf[4];
#pragma unroll
    for (int s = 0; s < 4; ++s) { bf16x8 z = {}; qf[s] = hd < 8 ? *(const GAS bf16x8*)(PROJ + (size_t)m * NPROJ + C_QL + hd * 128 + 32 * s + 8 * g) : z; }
    const float slope = exp2f(-(float)((hd & 7) + 1));
    const float sl2 = slope * LOG2E, c2 = 0.125f * LOG2E;
    float mrun = -1e30f, lsum = 0.f;
    f32x4 o[8];
#pragma unroll
    for (int i = 0; i < 8; ++i) o[i] = (f32x4){0.f, 0.f, 0.f, 0.f};
    LDS_WAIT();
    const int q4 = (lane & 15) >> 2, p4 = lane & 3;
    bf16x8 gn[8];
#pragma unroll
    for (int i = 0; i < 8; ++i) { const int n = lane + 64 * i, row = n >> 4, ch = n & 15; unsigned id = idl[row]; id = id == 0xFFFFu ? 0u : id; gn[i] = *(const GAS bf16x8*)(cb + (size_t)id * 128 + ch * 8); }
    for (int c = 0; c < 8; ++c) {
#pragma unroll
        for (int i = 0; i < 8; ++i) { const int n = lane + 64 * i, row = n >> 4, ch = n & 15; *(LAS bf16x8*)(img + off_b(row, ch)) = gn[i]; }
        if (c + 1 < 8) {
#pragma unroll
            for (int i = 0; i < 8; ++i) { const int n = lane + 64 * i, row = n >> 4, ch = n & 15; unsigned id = idl[32 * (c + 1) + row]; id = id == 0xFFFFu ? 0u : id; gn[i] = *(const GAS bf16x8*)(cb + (size_t)id * 128 + ch * 8); }
        }
        LDS_WAIT();
        float sv[8]; float mx = -1e30f;
#pragma unroll
        for (int rb = 0; rb < 2; ++rb) {
            f32x4 acc = {0.f, 0.f, 0.f, 0.f};
#pragma unroll
            for (int s = 0; s < 4; ++s) { const bf16x8 a = *(const LAS bf16x8*)(img + off_b((lane & 15) + 16 * rb, 4 * s + g)); acc = __builtin_amdgcn_mfma_f32_16x16x32_bf16(a, qf[s], acc, 0, 0, 0); }
            const u32x2 iw = *(const LAS u32x2*)(idl + 32 * c + 16 * rb + 4 * g);
            const unsigned ids[4] = {iw.x & 0xFFFFu, iw.x >> 16, iw.y & 0xFFFFu, iw.y >> 16};
#pragma unroll
            for (int e = 0; e < 4; ++e) { const bool ok = ids[e] != 0xFFFFu; const float v = ok ? (acc[e] * c2 - sl2 * (float)(t - (int)ids[e])) : -1e30f; sv[4 * rb + e] = v; mx = fmaxf(mx, v); }
        }
        mx = fmaxf(mx, __shfl_xor(mx, 16)); mx = fmaxf(mx, __shfl_xor(mx, 32));
        const float mnew = fmaxf(mrun, mx);
        const float alpha = ex2(mrun - mnew);
        mrun = mnew;
        float pv[8]; float ps = 0.f;
#pragma unroll
        for (int e = 0; e < 8; ++e) { const float pe = (sv[e] > -1e29f) ? ex2(sv[e] - mnew) : 0.f; pv[e] = pe; ps += pe; }
        lsum = lsum * alpha + ps;
        v4u pw; pw.x = pkbf(pv[0], pv[1]); pw.y = pkbf(pv[2], pv[3]); pw.z = pkbf(pv[4], pv[5]); pw.w = pkbf(pv[6], pv[7]);
        const bf16x8 pb = __builtin_bit_cast(bf16x8, pw);
#pragma unroll
        for (int mt = 0; mt < 8; ++mt) {
            const s16x4 lo = tr16(img + off_b(4 * g + q4, 2 * mt + (p4 >> 1)) + 8 * (p4 & 1));
            const s16x4 hi4 = tr16(img + off_b(16 + 4 * g + q4, 2 * mt + (p4 >> 1)) + 8 * (p4 & 1));
            const bf16x8 a = {lo[0], lo[1], lo[2], lo[3], hi4[0], hi4[1], hi4[2], hi4[3]};
            o[mt] = o[mt] * alpha;
            o[mt] = __builtin_amdgcn_mfma_f32_16x16x32_bf16(a, pb, o[mt], 0, 0, 0);
        }
        LDS_WAIT();
    }
    lsum += __shfl_xor(lsum, 16); lsum += __shfl_xor(lsum, 32);
    const float linv = 1.0f / lsum;
    if (hd < 8) {
        bf16* op = MIX + (size_t)m * KOUT + 512 + hd * 128 + 4 * g;
#pragma unroll
        for (int mt = 0; mt < 8; ++mt) { u32x2 w; w.x = pkbf(o[mt][0] * linv, o[mt][1] * linv); w.y = pkbf(o[mt][2] * linv, o[mt][3] * linv); *(GAS u32x2*)(op + 16 * mt) = w; }
    }
}
}
struct Args { const float* in[14]; float* out; unsigned char* ws; int ph_lo, ph_hi; };
__global__ void __launch_bounds__(NWAVES * 64, 2) fwd(Args args) {
    extern __shared__ __attribute__((aligned(16))) unsigned char lds[];
    Frame F;
    F.lds = (LAS unsigned char*)lds;
    F.MISC = (volatile LAS unsigned*)(F.lds + MISC_OFF);
    F.tid = threadIdx.x; F.lane = F.tid & 63; F.wave = __builtin_amdgcn_readfirstlane(F.tid >> 6);
    F.G = gridDim.x;
    unsigned char* ws = args.ws;
    F.ctl = (gu32*)(ws + WS_CTL);
    F.x = args.in[0]; F.c = args.in[1]; F.w_ada = args.in[2]; F.b_ada = args.in[3]; F.g_attn = args.in[4]; F.w_in = args.in[5]; F.kv_g = args.in[6];
    F.w_uk = args.in[7]; F.w_uv = args.in[8]; F.w_out = args.in[9]; F.g_ffn = args.in[10]; F.w_gu = args.in[11]; F.w_down = args.in[12]; F.g_final = args.in[13];
    F.out = args.out;
    F.MOD = (float*)(ws + WS_MOD);
    F.WIN = (bf16*)(ws + WS_WIN); F.WOUT = (bf16*)(ws + WS_WOUT); F.WGU = (bf16*)(ws + WS_WGU); F.WDN = (bf16*)(ws + WS_WDN);
    F.CKVN = (bf16*)(ws + WS_CKVN); F.IDX = (unsigned short*)(ws + WS_IDX); F.XN = (bf16*)(ws + WS_XN); F.MIX = (bf16*)(ws + WS_MIX); F.PROJ = (bf16*)(ws + WS_PROJ); F.HB = (bf16*)(ws + WS_H);
    for (int u = F.tid; u < (LDS_BYTES - LDSCTL_OFF) / 4; u += NWAVES * 64) ((LAS unsigned*)(F.lds + LDSCTL_OFF))[u] = 0u;
    __syncthreads();
    XcdBarrier bar = xcd_barrier_post((unsigned*)(F.ctl + CW_BAR), F.MISC + 8);
    const int lo = args.ph_lo, hi = args.ph_hi;
#define IN(k) (lo <= (k) && (k) < hi)
#define BOTH(k) (IN(k) && IN((k) + 1))
#define GRID_BAR() xcd_barrier(bar)

    if (IN(0)) { p0_prologue(F); if (BOTH(0)) GRID_BAR(); }
    if (IN(1)) { modnorm_rows(F, F.x, F.g_attn, 1, 0, F.XN); if (BOTH(1)) GRID_BAR(); }
    if (IN(2)) {
        pg8::Gemm g{F.XN, F.WIN, M, NPROJ, D}; pg8::StaticOrder S; S.init(M, NPROJ, F.G, (int)blockIdx.x);
        pg8::EpiBf16<0> E{F.PROJ, NPROJ, nullptr, 0, 0, 1.f};
        pg8::gemm_phase<pg8::EpiBf16<0>, pg8::StaticOrder, true, true>(F.lds + RING_OFF, g, S, E);
        if (BOTH(2)) GRID_BAR();
    }
    if (IN(3)) {
        ckv_norm_rows(F);
        for (int u = blockIdx.x; u < 512; u += F.G) ga::unit(u >> 6, (u >> 3) & 7, u & 7, F.PROJ, F.MIX, F.lds + RING_OFF + F.wave * ga::VTILE, F.lane, F.wave);
        __syncthreads();
        for (int i = 0; i * F.G < 2048; ++i) { const int gp = (i & 1) ? (F.G - 1 - (int)blockIdx.x) : (int)blockIdx.x; const int L = i * F.G + gp;
            if (L < 2048) tk::unit(L & 7, L >> 3, F.PROJ, F.IDX, F.lds + RING_OFF, (LAS unsigned*)(F.lds + EX_OFF), F.ctl + CW_ERR, F.tid, F.lane, F.wave); }
        if (BOTH(3)) GRID_BAR();
    }
    if (IN(4)) {
        const int gw = blockIdx.x * NWAVES + F.wave, NGW = F.G * NWAVES;
        for (int m = gw; m < M; m += NGW) sp::query(m, F.PROJ, F.CKVN, F.IDX, F.MIX, F.lds + RING_OFF + F.wave * sp::WAVE_BYTES, F.lane);
        if (BOTH(4)) GRID_BAR();
    }
    if (IN(5)) {
        pg8::Gemm g{F.MIX, F.WOUT, M, D, KOUT}; pg8::StaticOrder S; S.init(M, D, F.G, (int)blockIdx.x);
        pg8::EpiGateRes E{F.x, F.out, D, F.MOD + 2 * 1024, 6144};
        pg8::gemm_phase<pg8::EpiGateRes, pg8::StaticOrder, true, true>(F.lds + RING_OFF, g, S, E);
        if (BOTH(5)) GRID_BAR();
    }
    if (IN(6)) { modnorm_rows(F, F.out, F.g_ffn, 4, 3, F.XN); if (BOTH(6)) GRID_BAR(); }
    if (IN(7)) {
        pg8::Gemm g{F.XN, F.WGU, M, NGU, D}; pg8::StaticOrder S; S.init(M, NGU, F.G, (int)blockIdx.x);
        pg8::EpiSwiGLU E{F.HB, DFF};
        pg8::gemm_phase<pg8::EpiSwiGLU, pg8::StaticOrder, true, true>(F.lds + RING_OFF, g, S, E);
        if (BOTH(7)) GRID_BAR();
    }
    if (IN(8)) {
        pg8::Gemm g{F.HB, F.WDN, M, D, DFF}; pg8::StaticOrder S; S.init(M, D, F.G, (int)blockIdx.x);
        pg8::EpiGateRes E{F.out, F.out, D, F.MOD + 5 * 1024, 6144};
        pg8::gemm_phase<pg8::EpiGateRes, pg8::StaticOrder, true, true>(F.lds + RING_OFF, g, S, E);
        if (BOTH(8)) GRID_BAR();
    }
    if (IN(9)) {
        final_norm_rows(F);
        const unsigned bad = __hip_atomic_load(F.ctl + CW_ERR, RLX_AGENT) | __hip_atomic_load((gu32*)((unsigned*)(F.ctl + CW_BAR) + XB_TMO), RLX_AGENT);
        if (bad != 0u && blockIdx.x == 0 && F.tid < 64) F.out[F.tid] = __builtin_nanf("");
    }
#undef IN
#undef BOTH
#undef GRID_BAR
}

#ifndef MK_N_LAUNCHES
#define MK_N_LAUNCHES 1
#endif
extern "C" void kernel_launch(void* const* d_in, const int* in_sizes, int n_in, void* d_out, int out_size, void* d_ws, size_t ws_size, hipStream_t stream) {
    static int grid = 0;
    if (grid == 0) {
        if (n_in != 14 || in_sizes[0] != M * D || out_size != M * D || ws_size < WS_END) { fprintf(stderr, "kernel_launch: unexpected shapes: n_in %d in0 %d out %d ws %zu (need %zu)\n", n_in, n_in > 0 ? in_sizes[0] : -1, out_size, ws_size, (size_t)WS_END); grid = -1; return; }
        int dev = 0, cus = 0, per_cu = 0;
        if (hipGetDevice(&dev) != hipSuccess || hipDeviceGetAttribute(&cus, hipDeviceAttributeMultiprocessorCount, dev) != hipSuccess) { grid = -1; return; }
        if (hipFuncSetAttribute((const void*)fwd, hipFuncAttributeMaxDynamicSharedMemorySize, LDS_BYTES) != hipSuccess) { fprintf(stderr, "kernel_launch: hipFuncSetAttribute failed\n"); grid = -1; return; }
        if (hipOccupancyMaxActiveBlocksPerMultiprocessor(&per_cu, (const void*)fwd, NWAVES * 64, LDS_BYTES) != hipSuccess || per_cu < 1) fprintf(stderr, "kernel_launch: occupancy query reports %d\n", per_cu);
        (void)hipGetLastError();
        grid = cus;
    }
    if (grid < 0) return;
    if (hipMemsetAsync((char*)d_ws + WS_CTL, 0, CTL_ZERO_BYTES, stream) != hipSuccess) return;
    Args a{};
    for (int i = 0; i < 14; ++i) a.in[i] = (const float*)d_in[i];
    a.out = (float*)d_out; a.ws = (unsigned char*)d_ws;
#if MK_N_LAUNCHES == 1
    a.ph_lo = 0; a.ph_hi = 10;
    hipLaunchKernelGGL(fwd, dim3(grid), dim3(NWAVES * 64), LDS_BYTES, stream, a);
#else
    for (int p = 0; p < 10; ++p) { a.ph_lo = p; a.ph_hi = p + 1; hipLaunchKernelGGL(fwd, dim3(grid), dim3(NWAVES * 64), LDS_BYTES, stream, a); }
#endif
}
```

```cpp
#include <hip/hip_runtime.h>
#include <cstdio>
#include <cstdint>
namespace pg8 {
#define PG8_LAS __attribute__((address_space(3)))
typedef unsigned short bf16_t;
typedef short bf16x8 __attribute__((ext_vector_type(8)));
typedef float f32x4 __attribute__((ext_vector_type(4)));
typedef unsigned u32x4 __attribute__((ext_vector_type(4)));
constexpr int BM = 256, BK = 64, HALF = 128, HTB = HALF * BK * 2  , STAGE_BYTES = 8 * HTB, NXCD = 8, WGM = 8;

__host__ __device__ __forceinline__ int lds_byte(int r, int c) { const int st = (r >> 4) * 2 + (c >> 5), rr = r & 15, cc = c & 31, ob = rr * 64 + cc * 2; return st * 1024 + (ob ^ (((ob >> 9) & 1) << 5)); }
__host__ __device__ __forceinline__ void stage_rc(int b, int& R, int& C) { const int st = b / 1024, sb = b % 1024, swz = sb ^ (((sb >> 9) & 1) << 5); R = (st >> 1) * 16 + swz / 64; C = (st & 1) * 32 + (swz % 64) / 2; }
__host__ __device__ __forceinline__ int perm32(int rho) { const int n = rho >> 4, i = rho & 15; return 8 * (i >> 2) + 4 * n + (i & 3); }

struct Unit { int pm, pn; };
struct Gemm { const bf16_t* A; const bf16_t* Bt; int M, N, K; int sw = 0x7F7F7F7F, sa = 0x7F7F7F7F; };

struct StaticOrder {
    int nM, nN, nwg, G, c;
    __host__ __device__ void init(int M, int N, int G_, int c_) { nM = M / BM; nN = N / BM; nwg = nM * nN; G = G_; c = c_; }
    __host__ __device__ bool next(int i, Unit& u) const {
        const long L = (long)i * G + c; if (L >= nwg) return false;
        int wgid = (int)L; { const int q = nwg / NXCD, r = nwg % NXCD, xcd = wgid % NXCD, off = wgid / NXCD; wgid = (xcd < r ? xcd * (q + 1) : r * (q + 1) + (xcd - r) * q) + off; }
        const int nig = WGM * nN, gid = wgid / nig, fm = gid * WGM, gsz = (nM - fm) < WGM ? (nM - fm) : WGM;
        u.pm = fm + ((wgid % nig) % gsz); u.pn = (wgid % nig) / gsz; return true;
    }
    __device__ __forceinline__ void a_ready(const Unit&) const {}
    __device__ __forceinline__ void done(const Unit&) const {}
};

__device__ __forceinline__ unsigned cvt_pk_bf16(float lo, float hi) { unsigned r; asm volatile("v_cvt_pk_bf16_f32 %0, %1, %2" : "=v"(r) : "v"(lo), "v"(hi)); return r; }
typedef float f32x2 __attribute__((ext_vector_type(2)));
__device__ __forceinline__ f32x2 gelu_pk(f32x2 v) {
    const f32x2 av = __builtin_elementwise_abs(v), d = av * 0.2316418882f + 1.0f;
    f32x2 t; t.x = __builtin_amdgcn_rcpf(d.x); t.y = __builtin_amdgcn_rcpf(d.y);
    f32x2 q = t * 0.5307027145f + (-0.7265760135f); q = q * t + 0.7107068705f; q = q * t + (-0.142248368f); q = q * t + 0.127414796f; q = q * t;
    const f32x2 s = (v * v) * (-0.72134752044f);
    f32x2 e; e.x = __builtin_amdgcn_exp2f(s.x); e.y = __builtin_amdgcn_exp2f(s.y);
    const f32x2 m = v * (q * e), r = v - m;
    f32x2 o; o.x = v.x < 0.f ? m.x : r.x; o.y = v.y < 0.f ? m.y : r.y; return o;
}

template <int ACT  > struct EpiBf16 {
    static constexpr bool PERM = true, AFTER_DRAIN = false; static_assert(ACT == 0 || ACT == 1, "EpiBf16: ACT is 0 (none) or 1 (gelu_pk)");
    bf16_t* O; int ldc; const float* bias; int split_cols; size_t split_stride; float scale0;
    __device__ __forceinline__ void operator()(const f32x4 (&acc)[2][2][4][2], const Unit& u, int wr, int wc, int fr, int fq) const {
        const int row0 = u.pm * BM + wr * 64 + fr; int colt = u.pn * BM; bf16_t* base = O;
        float sc = 1.f; if (split_cols) { const int t = colt / split_cols; base += (size_t)t * split_stride; colt -= t * split_cols; if (t == 0) sc = scale0; }
        const int col0 = colt + wc * 32 + 8 * fq, bcol0 = u.pn * BM + wc * 32 + 8 * fq;
        f32x4 bv[2][2];
#pragma unroll
        for (int bj = 0; bj < 2; ++bj)
#pragma unroll
            for (int n = 0; n < 2; ++n) bv[bj][n] = bias ? *(const f32x4*)(bias + bcol0 + bj * HALF + 4 * n) : (f32x4){0.f, 0.f, 0.f, 0.f};
#pragma unroll
        for (int ai = 0; ai < 2; ++ai)
#pragma unroll
            for (int m = 0; m < 4; ++m) { bf16_t* rowp = base + (size_t)(row0 + ai * HALF + m * 16) * ldc + col0;
#pragma unroll
                for (int bj = 0; bj < 2; ++bj) { f32x4 v0 = acc[ai][bj][m][0] + bv[bj][0], v1 = acc[ai][bj][m][1] + bv[bj][1];
                    if (ACT == 1) { f32x2 a = gelu_pk((f32x2){v0[0], v0[1]}), b = gelu_pk((f32x2){v0[2], v0[3]}), c = gelu_pk((f32x2){v1[0], v1[1]}), d = gelu_pk((f32x2){v1[2], v1[3]});
                        v0 = (f32x4){a.x, a.y, b.x, b.y}; v1 = (f32x4){c.x, c.y, d.x, d.y}; }
                    v0 = v0 * sc; v1 = v1 * sc; u32x4 w; w.x = cvt_pk_bf16(v0[0], v0[1]); w.y = cvt_pk_bf16(v0[2], v0[3]); w.z = cvt_pk_bf16(v1[0], v1[1]); w.w = cvt_pk_bf16(v1[2], v1[3]);
                    *(u32x4*)(rowp + bj * HALF) = w; } }
    }
};
struct EpiGateRes {
    static constexpr bool PERM = false, AFTER_DRAIN = false;
    const float* base; float* out; int ldc; const float* gate; int gate_stride;
    __device__ __forceinline__ void operator()(const f32x4 (&acc)[2][2][4][2], const Unit& u, int wr, int wc, int fr, int fq) const {
        const int row0 = u.pm * BM + wr * 64 + fr, col0 = u.pn * BM + wc * 32 + 4 * fq;
        const float* g = gate + (size_t)((u.pm * BM) >> 12) * gate_stride + col0;
        f32x4 gv[2][2];
#pragma unroll
        for (int bj = 0; bj < 2; ++bj)
#pragma unroll
            for (int n = 0; n < 2; ++n) gv[bj][n] = *(const f32x4*)(g + bj * HALF + n * 16);
#pragma unroll
        for (int ai = 0; ai < 2; ++ai)
#pragma unroll
            for (int m = 0; m < 4; ++m) { const size_t off = (size_t)(row0 + ai * HALF + m * 16) * ldc + col0;
#pragma unroll
                for (int bj = 0; bj < 2; ++bj)
#pragma unroll
                    for (int n = 0; n < 2; ++n) { const f32x4 bs = *(const f32x4*)(base + off + bj * HALF + n * 16); const f32x4 o = bs + gv[bj][n] * acc[ai][bj][m][n]; *(f32x4*)(out + off + bj * HALF + n * 16) = o; }
                if (m & 1) asm volatile("" ::: "memory"); }
    }
};
struct EpiSwiGLU {
    static constexpr bool PERM = true, AFTER_DRAIN = false;
    bf16_t* O; int ldc;
    __device__ __forceinline__ static float silu_mul(float g, float u) { return g * __builtin_amdgcn_rcpf(1.0f + __builtin_amdgcn_exp2f(g * -1.4426950408889634f)) * u; }
    __device__ __forceinline__ void operator()(const f32x4 (&acc)[2][2][4][2], const Unit& u, int wr, int wc, int fr, int fq) const {
        const int row0 = u.pm * BM + wr * 64 + fr, col0 = u.pn * HALF + wc * 32 + 8 * fq;
#pragma unroll
        for (int ai = 0; ai < 2; ++ai)
#pragma unroll
            for (int m = 0; m < 4; ++m) { bf16_t* rowp = O + (size_t)(row0 + ai * HALF + m * 16) * ldc + col0;
                const f32x4 g0 = acc[ai][0][m][0], g1 = acc[ai][0][m][1], u0 = acc[ai][1][m][0], u1 = acc[ai][1][m][1];
                u32x4 w; w.x = cvt_pk_bf16(silu_mul(g0[0], u0[0]), silu_mul(g0[1], u0[1])); w.y = cvt_pk_bf16(silu_mul(g0[2], u0[2]), silu_mul(g0[3], u0[3]));
                w.z = cvt_pk_bf16(silu_mul(g1[0], u1[0]), silu_mul(g1[1], u1[1])); w.w = cvt_pk_bf16(silu_mul(g1[2], u1[2]), silu_mul(g1[3], u1[3]));
                *(u32x4*)rowp = w; }
    }
};
struct EpiSwiGLU8 {
    static constexpr bool PERM = true, AFTER_DRAIN = false;
    unsigned char* O; int ldc; float oscale;
    __device__ __forceinline__ void operator()(const f32x4 (&acc)[2][2][4][2], const Unit& u, int wr, int wc, int fr, int fq) const {
        const int row0 = u.pm * BM + wr * 64 + fr, col0 = u.pn * HALF + wc * 32 + 8 * fq;
#pragma unroll
        for (int ai = 0; ai < 2; ++ai)
#pragma unroll
            for (int m = 0; m < 4; ++m) { unsigned char* rowp = O + (size_t)(row0 + ai * HALF + m * 16) * ldc + col0;
                const f32x4 g0 = acc[ai][0][m][0], g1 = acc[ai][0][m][1], u0 = acc[ai][1][m][0], u1 = acc[ai][1][m][1];
                int w0 = __builtin_amdgcn_cvt_pk_fp8_f32(EpiSwiGLU::silu_mul(g0[0], u0[0]) * oscale, EpiSwiGLU::silu_mul(g0[1], u0[1]) * oscale, 0, false);
                w0 = __builtin_amdgcn_cvt_pk_fp8_f32(EpiSwiGLU::silu_mul(g0[2], u0[2]) * oscale, EpiSwiGLU::silu_mul(g0[3], u0[3]) * oscale, w0, true);
                int w1 = __builtin_amdgcn_cvt_pk_fp8_f32(EpiSwiGLU::silu_mul(g1[0], u1[0]) * oscale, EpiSwiGLU::silu_mul(g1[1], u1[1]) * oscale, 0, false);
                w1 = __builtin_amdgcn_cvt_pk_fp8_f32(EpiSwiGLU::silu_mul(g1[2], u1[2]) * oscale, EpiSwiGLU::silu_mul(g1[3], u1[3]) * oscale, w1, true);
                typedef int i32x2_ __attribute__((ext_vector_type(2)));
                *(i32x2_*)rowp = (i32x2_){w0, w1}; }
    }
};
template <class Epi, class Sched, bool ALIGN_EPI = false, bool SP2 = false, bool FP8 = false>
__device__ __forceinline__ void gemm_phase(PG8_LAS unsigned char* lds, const Gemm g, const Sched& S, const Epi& E) {
    int tid_ = threadIdx.x; asm volatile("" : "+v"(tid_));
    const int tid = tid_, wid = __builtin_amdgcn_readfirstlane(tid >> 6), lane = tid & 63, wr = wid >> 2, wc = wid & 3, fr = lane & 15, fq = lane >> 4;
    const int K = g.K, nt = K / BK;
    unsigned voffA[2], voffB[2];
#pragma unroll
    for (int i = 0; i < 2; ++i) { int R, C; stage_rc(tid * 16 + i * 8192, R, C); const int Rb = Epi::PERM ? ((R & ~31) + perm32(R & 31)) : R;
        voffA[i] = (unsigned)(R * K + C) * 2u; voffB[i] = (unsigned)(Rb * K + C) * 2u; }
    const size_t kstep = (size_t)(BK * 2);
    const size_t hstep = (size_t)HALF * K * 2;
    const size_t tstep = 2 * hstep;
    const unsigned ldsw = (unsigned)wid * 1024u;
    const int aoff = lds_byte(wr * 64 + fr, fq * 8), boff = lds_byte(wc * 32 + fr, fq * 8);
#define PG8_SA(b, h) (((b) * 2 + (h)) * HTB)
#define PG8_SB(b, h) ((4 + (b) * 2 + (h)) * HTB)
#define PG8_STAGE(bufoff, gbase, voff) do { _Pragma("unroll") for (int _i = 0; _i < 2; ++_i) \
        __builtin_amdgcn_global_load_lds((const unsigned*)((const char*)(gbase) + (voff)[_i]), (PG8_LAS unsigned*)(lds + (bufoff) + ldsw + _i * 8192), 16, 0, 0); } while (0)
#define PG8_LDA(dst, b, h) do { _Pragma("unroll") for (int m = 0; m < 4; ++m) { if constexpr (FP8) { const v4i_ lo_ = *(const PG8_LAS v4i_*)(lds + PG8_SA(b, h) + aoff + m * 2048), hi_ = *(const PG8_LAS v4i_*)(lds + PG8_SA(b, h) + aoff + m * 2048 + 1024); \
        dst##8[m] = __builtin_shufflevector(lo_, hi_, 0, 1, 2, 3, 4, 5, 6, 7); } else { _Pragma("unroll") for (int k = 0; k < 2; ++k) dst[m][k] = *(const PG8_LAS bf16x8*)(lds + PG8_SA(b, h) + aoff + m * 2048 + k * 1024); } } } while (0)
#define PG8_LDB(dst, b, h) do { _Pragma("unroll") for (int n = 0; n < 2; ++n) { if constexpr (FP8) { const v4i_ lo_ = *(const PG8_LAS v4i_*)(lds + PG8_SB(b, h) + boff + n * 2048), hi_ = *(const PG8_LAS v4i_*)(lds + PG8_SB(b, h) + boff + n * 2048 + 1024); \
        dst##8[n] = __builtin_shufflevector(lo_, hi_, 0, 1, 2, 3, 4, 5, 6, 7); } else { _Pragma("unroll") for (int k = 0; k < 2; ++k) dst[n][k] = *(const PG8_LAS bf16x8*)(lds + PG8_SB(b, h) + boff + n * 2048 + k * 1024); } } } while (0)
#define PG8_MMA(ai, bj, At, Bt) do { __builtin_amdgcn_s_setprio(1); _Pragma("unroll") for (int m = 0; m < 4; ++m) _Pragma("unroll") for (int n = 0; n < 2; ++n) { \
        if constexpr (FP8) asm volatile("v_mfma_scale_f32_16x16x128_f8f6f4 %0, %1, %2, %0, %3, %4 op_sel_hi:[0,0,0]" : "+v"(acc[ai][bj][m][n]) : "v"(Bt##8[n]), "v"(At##8[m]), "v"(sw_), "v"(sa_));   \
        else { _Pragma("unroll") for (int k = 0; k < 2; ++k) acc[ai][bj][m][n] = __builtin_amdgcn_mfma_f32_16x16x32_bf16(Bt[n][k], At[m][k], acc[ai][bj][m][n], 0, 0, 0); } } \
        __builtin_amdgcn_s_setprio(0); } while (0)
#define PG8_WAIT_V(n) asm volatile("s_waitcnt vmcnt(" #n ")" ::: "memory")
#define PG8_WAIT_L(n) asm volatile("s_waitcnt lgkmcnt(" #n ")" ::: "memory")
#define PG8_BAR __builtin_amdgcn_s_barrier()
#define PG8_SCHED __builtin_amdgcn_sched_barrier(0)
    Unit cur, nxt; int ui = 0;
    if (!S.next(0, cur)) return;
    f32x4 acc[2][2][4][2];
#pragma unroll
    for (int a = 0; a < 2; ++a)
#pragma unroll
        for (int b = 0; b < 2; ++b)
#pragma unroll
            for (int m = 0; m < 4; ++m)
#pragma unroll
                for (int n = 0; n < 2; ++n) acc[a][b][m][n] = (f32x4){0.f, 0.f, 0.f, 0.f};
    typedef int v4i_ __attribute__((ext_vector_type(4))); typedef int v8i_ __attribute__((ext_vector_type(8)));
    bf16x8 At[4][2], B0[2][2], B1[2][2]; v8i_ At8[4], B08[2], B18[2];
    const int sw_ = g.sw, sa_ = g.sa;
    const char* cA = (const char*)g.A + (size_t)cur.pm * tstep; const char* cB = (const char*)g.Bt + (size_t)cur.pn * tstep;
    S.a_ready(cur);
    if constexpr (SP2) {
        PG8_STAGE(PG8_SB(0, 0), cB, voffB); PG8_STAGE(PG8_SB(0, 1), cB + hstep, voffB); PG8_STAGE(PG8_SA(0, 0), cA, voffA); PG8_STAGE(PG8_SA(0, 1), cA + hstep, voffA);
        if (wr == 1) PG8_BAR;
        PG8_WAIT_V(2); PG8_BAR;
        PG8_STAGE(PG8_SB(1, 0), cB + kstep, voffB); PG8_STAGE(PG8_SA(1, 0), cA + kstep, voffA); PG8_STAGE(PG8_SB(1, 1), cB + hstep + kstep, voffB);
        PG8_WAIT_V(6); PG8_BAR;
    } else {
        PG8_STAGE(PG8_SB(0, 0), cB, voffB); PG8_STAGE(PG8_SA(0, 0), cA, voffA); PG8_STAGE(PG8_SB(0, 1), cB + hstep, voffB); PG8_STAGE(PG8_SA(0, 1), cA + hstep, voffA);
        if (wr == 1) PG8_BAR;
        PG8_WAIT_V(4); PG8_BAR;
        PG8_STAGE(PG8_SB(1, 0), cB + kstep, voffB); PG8_STAGE(PG8_SA(1, 0), cA + kstep, voffA); PG8_STAGE(PG8_SB(1, 1), cB + hstep + kstep, voffB);
        PG8_WAIT_V(6); PG8_BAR;
    }
    for (;;) {
        const bool has_next = S.next(ui + 1, nxt);
        const char* nA = has_next ? (const char*)g.A + (size_t)nxt.pm * tstep : cA; const char* nB = has_next ? (const char*)g.Bt + (size_t)nxt.pn * tstep : cB;
        for (int t = 0; t < nt; t += 2) {
            const bool last = (t == nt - 2);
            const char* a1 = cA + (size_t)(t + 1) * kstep;
            const char* a2 = last ? nA : cA + (size_t)(t + 2) * kstep; const char* b2 = last ? nB : cB + (size_t)(t + 2) * kstep;
            const char* a3 = a2 + kstep; const char* b3 = b2 + kstep;
            if (last && has_next) S.a_ready(nxt);
            if constexpr (SP2) {
            PG8_LDB(B0, 0, 0); PG8_LDB(B1, 0, 1); PG8_SCHED; PG8_LDA(At, 0, 0); PG8_STAGE(PG8_SA(1, 1), a1 + hstep, voffA);
            PG8_WAIT_V(8); PG8_WAIT_L(0); PG8_BAR; PG8_MMA(0, 0, At, B0); PG8_MMA(0, 1, At, B1); PG8_BAR; PG8_SCHED;
            PG8_LDA(At, 0, 1); PG8_STAGE(PG8_SB(0, 0), b2, voffB); PG8_STAGE(PG8_SB(0, 1), b2 + hstep, voffB); PG8_STAGE(PG8_SA(0, 0), a2, voffA);
            PG8_WAIT_V(8); PG8_WAIT_L(0); PG8_BAR; PG8_MMA(1, 0, At, B0); PG8_MMA(1, 1, At, B1); PG8_BAR; PG8_SCHED;
            PG8_LDB(B0, 1, 0); PG8_LDB(B1, 1, 1); PG8_SCHED; PG8_LDA(At, 1, 0); PG8_STAGE(PG8_SA(0, 1), a2 + hstep, voffA);
            PG8_WAIT_V(8); PG8_WAIT_L(0); PG8_BAR; PG8_MMA(0, 0, At, B0); PG8_MMA(0, 1, At, B1); PG8_BAR; PG8_SCHED;
            PG8_LDA(At, 1, 1); PG8_STAGE(PG8_SB(1, 0), b3, voffB); PG8_STAGE(PG8_SB(1, 1), b3 + hstep, voffB); PG8_STAGE(PG8_SA(1, 0), a3, voffA);
            PG8_WAIT_V(8); PG8_WAIT_L(0); PG8_BAR; PG8_MMA(1, 0, At, B0); PG8_MMA(1, 1, At, B1); PG8_BAR; PG8_SCHED;
            } else {
            PG8_LDB(B0, 0, 0); PG8_SCHED; PG8_LDA(At, 0, 0); PG8_STAGE(PG8_SA(1, 1), a1 + hstep, voffA);
            PG8_WAIT_L(8); PG8_BAR; PG8_WAIT_L(0); PG8_MMA(0, 0, At, B0); PG8_BAR; PG8_SCHED;
            PG8_LDB(B1, 0, 1); PG8_STAGE(PG8_SB(0, 0), b2, voffB);
            PG8_BAR; PG8_WAIT_L(0); PG8_MMA(0, 1, At, B1); PG8_BAR;
            PG8_LDA(At, 0, 1); PG8_STAGE(PG8_SA(0, 0), a2, voffA);
            PG8_BAR; PG8_WAIT_L(0); PG8_MMA(1, 0, At, B0); PG8_BAR; PG8_SCHED;
            PG8_STAGE(PG8_SB(0, 1), b2 + hstep, voffB);
            PG8_WAIT_V(6); PG8_BAR; PG8_MMA(1, 1, At, B1); PG8_BAR;
            PG8_LDB(B0, 1, 0); PG8_SCHED; PG8_LDA(At, 1, 0); PG8_STAGE(PG8_SA(0, 1), a2 + hstep, voffA);
            PG8_WAIT_L(8); PG8_BAR; PG8_WAIT_L(0); PG8_MMA(0, 0, At, B0); PG8_BAR; PG8_SCHED;
            PG8_LDB(B1, 1, 1); PG8_STAGE(PG8_SB(1, 0), b3, voffB);
            PG8_BAR; PG8_WAIT_L(0); PG8_MMA(0, 1, At, B1); PG8_BAR;
            PG8_LDA(At, 1, 1); PG8_STAGE(PG8_SA(1, 0), a3, voffA);
            PG8_BAR; PG8_WAIT_L(0); PG8_MMA(1, 0, At, B0); PG8_BAR; PG8_SCHED;
            PG8_STAGE(PG8_SB(1, 1), b3 + hstep, voffB);
            PG8_WAIT_V(6); PG8_BAR; PG8_MMA(1, 1, At, B1); PG8_BAR;
            }
        }
        if constexpr (FP8) asm volatile("s_nop 15\n\ts_nop 15" ::: "memory");
        if constexpr (ALIGN_EPI) { if (wr == 0) PG8_BAR; }
        if constexpr (!Epi::AFTER_DRAIN) { E(acc, cur, wr, wc, fr, fq); S.done(cur); }
        if (!has_next) break;
#pragma unroll
        for (int a = 0; a < 2; ++a)
#pragma unroll
            for (int b = 0; b < 2; ++b)
#pragma unroll
                for (int m = 0; m < 4; ++m)
#pragma unroll
                    for (int n = 0; n < 2; ++n) acc[a][b][m][n] = (f32x4){0.f, 0.f, 0.f, 0.f};
        cur = nxt; cA = nA; cB = nB; ++ui;
        if constexpr (ALIGN_EPI) { if (wr == 1) PG8_BAR; }
    }
    PG8_WAIT_V(0);
    if constexpr (!ALIGN_EPI) { if (wr == 0) PG8_BAR; }
    PG8_BAR;
    if constexpr (Epi::AFTER_DRAIN) { E.fused(acc, cur, wr, wc, fr, fq, lds, wid, lane); S.done(cur); }
#undef PG8_SA
#undef PG8_SB
#undef PG8_STAGE
#undef PG8_LDA
#undef PG8_LDB
#undef PG8_MMA
#undef PG8_WAIT_V
#undef PG8_WAIT_L
#undef PG8_BAR
#undef PG8_SCHED
}
}
constexpr int NWAVES = 8;
constexpr int BATCH = 8, T = 4096, D = 1024, M = BATCH * T;
constexpr int DIN = 2760;
constexpr int NPROJ = 3328;
constexpr int C_QA = 0, C_KA = 512, C_VA = 1024, C_QL = 1536, C_CKV = 2560, C_QI = 2688, C_KI = 3200, C_WI = 3264, C_END = 3272;
constexpr int KOUT = 1536;
constexpr int DFF = 2816, NGU = 2 * DFF;
constexpr int TOPK = 256, RLAT = 128;
constexpr float EPS = 1e-6f;
constexpr float LOG2E = 1.4426950408889634f;
constexpr float IDX_SCALE = 0.044194173824159216f;
#ifndef FFN_FP8
#define FFN_FP8 1
#endif
constexpr float W8_SCALE = 64.f, X8_SCALE = 8.f, H8_SCALE = 16.f;
constexpr int E8_W = 0x7F7F7F7F - 0x06060606, E8_X = 0x7F7F7F7F - 0x03030303, E8_H = 0x7F7F7F7F - 0x04040404;

constexpr size_t MiB = 1u << 20;
constexpr size_t WS_CTL = 0, CTL_ZERO_BYTES = 1 * MiB;
constexpr size_t WS_MOD = 1 * MiB;
constexpr size_t WS_WIN = 2 * MiB;
constexpr size_t WS_WOUT = 9 * MiB;
constexpr size_t WS_WGU = 12 * MiB;
constexpr size_t WS_WDN = 23 * MiB;
constexpr size_t WS_CKVN = 29 * MiB;
constexpr size_t WS_IDX = 37 * MiB;
constexpr size_t WS_XN = 54 * MiB;
constexpr size_t WS_MIX = 118 * MiB;
constexpr size_t WS_PROJ = 214 * MiB;
constexpr size_t WS_H = WS_PROJ;
constexpr size_t WS_END = 422 * MiB;
static_assert(WS_WIN + (size_t)NPROJ * D * 2 <= WS_WOUT && WS_WOUT + (size_t)D * KOUT * 2 <= WS_WGU && WS_WGU + (size_t)NGU * D * 2 <= WS_WDN && WS_WDN + (size_t)D * DFF * 2 <= WS_CKVN, "ws map 1");
static_assert(WS_CKVN + (size_t)M * 128 * 2 <= WS_IDX && WS_IDX + (size_t)M * 256 * 2 <= WS_XN && WS_XN + (size_t)M * D * 2 <= WS_MIX && WS_MIX + (size_t)M * KOUT * 2 <= WS_PROJ && WS_PROJ + (size_t)M * NPROJ * 2 <= WS_END, "ws map 2");
constexpr int CW_TMO = 0, CW_CODE = 1, CW_ERR = 2;
constexpr int CW_BAR = 4096;

constexpr int RING_OFF = 0, RING_BYTES = 131072;
constexpr int LDSCTL_OFF = RING_BYTES, MISC_OFF = LDSCTL_OFF + 320;
constexpr int EX_OFF = LDSCTL_OFF + 512, EX_BYTES = 1024 + 8 * 3072;
constexpr int LDS_BYTES = EX_OFF + EX_BYTES;
#define GAS __attribute__((address_space(1)))
#define LAS __attribute__((address_space(3)))
typedef unsigned short bf16;
typedef unsigned v4u __attribute__((ext_vector_type(4)));
typedef float f32x4 __attribute__((ext_vector_type(4)));
typedef short bf16x8 __attribute__((ext_vector_type(8)));
typedef GAS unsigned gu32;
typedef GAS unsigned long long gu64;
#define RLX_AGENT __ATOMIC_RELAXED, __HIP_MEMORY_SCOPE_AGENT
#define LDS_WAIT() asm volatile("s_waitcnt lgkmcnt(0)" ::: "memory")
#define VM_WAIT() asm volatile("s_waitcnt vmcnt(0)" ::: "memory")
__device__ __forceinline__ unsigned long long rt() { return __builtin_amdgcn_s_memrealtime(); }
__device__ __forceinline__ unsigned f2bf(float f) { unsigned u = __builtin_bit_cast(unsigned, f); return (u + 0x7fffu + ((u >> 16) & 1u)) >> 16; }
__device__ __forceinline__ unsigned pk2(float lo, float hi) { return f2bf(lo) | (f2bf(hi) << 16); }
#define XB_TMO      128
#define XB_XCNT(j)  (256  + 64 * (j))
#define XB_XSUB(j)  (1280 + 64 * (j))
#define XB_XGEN(j)  (2304 + 64 * (j))
#define XB_TOP      3328
#define XB_TOPGEN   3392
#define XCD_BAR_WORDS 3456
#define XB_SPIN_CAP (1u << 18)

__device__ __forceinline__ unsigned xb_ld(unsigned* p)              { return __hip_atomic_load(p, __ATOMIC_RELAXED, __HIP_MEMORY_SCOPE_AGENT); }
__device__ __forceinline__ unsigned xb_add(unsigned* p, unsigned v) { return __hip_atomic_fetch_add(p, v, __ATOMIC_RELAXED, __HIP_MEMORY_SCOPE_AGENT); }
__device__ __forceinline__ unsigned xb_xcc_id() { return (unsigned)__builtin_amdgcn_s_getreg((3 << 11) | 20) & 0xFu; }
#define XB_SPIN(cond, bar) do { unsigned _sp = 0; while (cond) { __builtin_amdgcn_s_sleep(1); \
    if ((++_sp & 255u) == 0u) { if (xb_ld(&(bar)[XB_TMO])) break; if (_sp > XB_SPIN_CAP) { atomicAdd(&(bar)[XB_TMO], 1u); break; } } } } while (0)

struct XcdBarrier {
    unsigned* bar; unsigned x;
    volatile LAS unsigned* st;
};

__device__ __forceinline__ XcdBarrier xcd_barrier_post(unsigned* bar, volatile LAS unsigned* st) {
    XcdBarrier b; b.bar = bar; b.x = xb_xcc_id(); b.st = st;
    if (threadIdx.x == 0) (void)xb_add(&bar[XB_XCNT(b.x)], 1u);
    return b;
}
__device__ __forceinline__ void xcd_barrier_complete(unsigned* bar, unsigned x, unsigned& nloc, unsigned& nx) {
    const unsigned G = gridDim.x * gridDim.y * gridDim.z;
    unsigned sum, cnt, mine, sp = 0u;
    for (;;) {
        sum = 0u; cnt = 0u; mine = 0u;
#pragma unroll
        for (unsigned j = 0; j < 16; ++j) { const unsigned c = xb_ld(&bar[XB_XCNT(j)]); sum += c; cnt += (c > 0u) ? 1u : 0u; mine = (j == x) ? c : mine; }
        if (sum == G) break;
        __builtin_amdgcn_s_sleep(1);
        if ((++sp & 255u) == 0u) { if (xb_ld(&bar[XB_TMO])) break; if (sp > XB_SPIN_CAP) { atomicAdd(&bar[XB_TMO], 1u); break; } }
    }
    nloc = mine > 0u ? mine : 1u; nx = cnt > 0u ? cnt : 1u;
}

__device__ __forceinline__ void xcd_barrier(const XcdBarrier& b) {
    asm volatile("s_waitcnt vmcnt(0)" ::: "memory");
    __syncthreads();
    if (threadIdx.x == 0) {
        unsigned* bar = b.bar;
        __builtin_amdgcn_s_waitcnt(0);
        unsigned nloc = b.st[0], nx = b.st[1];
        if (nloc == 0u) { xcd_barrier_complete(bar, b.x, nloc, nx); b.st[0] = nloc; b.st[1] = nx; }
        const unsigned old = xb_add(&bar[XB_XSUB(b.x)], 1u);
        const unsigned gen = old / nloc;
        if (old + 1u == (gen + 1u) * nloc) {
            __builtin_amdgcn_fence(__ATOMIC_RELEASE, "agent");
            asm volatile("s_waitcnt vmcnt(0)" ::: "memory");
            const unsigned og = xb_add(&bar[XB_TOP], 1u);
            const unsigned tg = og / nx;
            if (og + 1u == (tg + 1u) * nx) xb_add(&bar[XB_TOPGEN], 1u);
            else XB_SPIN(xb_ld(&bar[XB_TOPGEN]) == tg, bar);
            __builtin_amdgcn_fence(__ATOMIC_ACQUIRE, "agent");
            xb_add(&bar[XB_XGEN(b.x)], 1u);
            asm volatile("s_waitcnt vmcnt(0)" ::: "memory");
        } else {
            XB_SPIN(xb_ld(&bar[XB_XGEN(b.x)]) == gen, bar);
            __builtin_amdgcn_fence(__ATOMIC_ACQUIRE, "agent");
            asm volatile("s_waitcnt vmcnt(0)" ::: "memory");
        }
    }
    __syncthreads();
}
typedef float f32x16 __attribute__((ext_vector_type(16)));
typedef short s16x4 __attribute__((ext_vector_type(4)));
typedef unsigned u32x2 __attribute__((ext_vector_type(2)));
typedef float f32x2_t __attribute__((ext_vector_type(2)));
typedef __bf16 bf16x2_t __attribute__((ext_vector_type(2)));
__device__ __forceinline__ unsigned pkbf(float lo, float hi) { f32x2_t v = {lo, hi}; bf16x2_t b = __builtin_convertvector(v, bf16x2_t); return __builtin_bit_cast(unsigned, b); }
__device__ __forceinline__ float bf2f(unsigned short h) { return __builtin_bit_cast(float, (unsigned)h << 16); }
__device__ __forceinline__ float bflo(unsigned w) { return __builtin_bit_cast(float, w << 16); }
__device__ __forceinline__ float bfhi(unsigned w) { return __builtin_bit_cast(float, w & 0xffff0000u); }
__device__ __forceinline__ float ex2(float x) { return __builtin_amdgcn_exp2f(x); }
__device__ __forceinline__ float swap32_max(float v) { auto rr = __builtin_amdgcn_permlane32_swap(__float_as_uint(v), __float_as_uint(v), false, false); return fmaxf(__uint_as_float(rr[0]), __uint_as_float(rr[1])); }
__device__ __forceinline__ float swap32_sum(float v) { auto rr = __builtin_amdgcn_permlane32_swap(__float_as_uint(v), __float_as_uint(v), false, false); return __uint_as_float(rr[0]) + __uint_as_float(rr[1]); }
typedef short v4i16_t __attribute__((ext_vector_type(4)));
__device__ __forceinline__ s16x4 tr16(LAS const unsigned char* p) { return __builtin_bit_cast(s16x4, __builtin_amdgcn_ds_read_tr16_b64_v4i16((LAS v4i16_t*)p)); }

struct Frame {
    LAS unsigned char* lds;
    volatile LAS unsigned* MISC;
    gu32* ctl;
    int tid, lane, wave;
    int G;
    const float *x, *c, *w_ada, *b_ada, *g_attn, *w_in, *kv_g, *w_uk, *w_uv, *w_out, *g_ffn, *w_gu, *w_down, *g_final;
    float* out;
    float* MOD;
    bf16 *WIN, *WOUT, *WGU, *WDN, *CKVN, *XN, *MIX, *PROJ, *HB;
    unsigned short* IDX;
};
__device__ __forceinline__ float wave_sum(float v) {
#pragma unroll
    for (int o = 1; o < 64; o <<= 1) v += __shfl_xor(v, o);
    return v;
}

__device__ __forceinline__ void tr_item(const float* W, int ldw, int k0, int n0, int nvalid, bf16* WT, int ldt, int drow0, LAS float* scr, int lane) {
#pragma unroll 8
    for (int i = 0; i < 32; ++i) { const int kk = 2 * i + (lane >> 5), nn = lane & 31; scr[kk * 33 + nn] = nn < nvalid ? W[(size_t)(k0 + kk) * ldw + n0 + nn] : 0.f; }
    LDS_WAIT(); asm volatile("" ::: "memory");
    const int c = lane & 7;
#pragma unroll
    for (int j = 0; j < 4; ++j) { const int n = (lane >> 3) + 8 * j; const LAS float* s = scr + (8 * c) * 33 + n;
        v4u o; o.x = pk2(s[0 * 33], s[1 * 33]); o.y = pk2(s[2 * 33], s[3 * 33]); o.z = pk2(s[4 * 33], s[5 * 33]); o.w = pk2(s[6 * 33], s[7 * 33]);
        if (n < nvalid) *(GAS v4u*)(WT + (size_t)(drow0 + n) * ldt + k0 + 8 * c) = o; }
    LDS_WAIT(); asm volatile("" ::: "memory");
}
__device__ __forceinline__ void tr_item8(const float* W, int ldw, int k0, int n0, unsigned char* WT, int ldt, int drow0, float wscale, LAS float* scr, int lane) {
#pragma unroll 8
    for (int i = 0; i < 32; ++i) { const int kk = 2 * i + (lane >> 5), nn = lane & 31; scr[kk * 33 + nn] = W[(size_t)(k0 + kk) * ldw + n0 + nn]; }
    LDS_WAIT(); asm volatile("" ::: "memory");
    const int c = lane & 3;
#pragma unroll
    for (int j = 0; j < 2; ++j) { const int n = (lane >> 2) + 16 * j; const LAS float* s = scr + (16 * c) * 33 + n;
        int w[4];
#pragma unroll
        for (int q = 0; q < 4; ++q) { int t = __builtin_amdgcn_cvt_pk_fp8_f32(s[(4 * q) * 33] * wscale, s[(4 * q + 1) * 33] * wscale, 0, false); w[q] = __builtin_amdgcn_cvt_pk_fp8_f32(s[(4 * q + 2) * 33] * wscale, s[(4 * q + 3) * 33] * wscale, t, true); }
        *(GAS v4u*)(WT + (size_t)(drow0 + n) * ldt + k0 + 16 * c) = (v4u){(unsigned)w[0], (unsigned)w[1], (unsigned)w[2], (unsigned)w[3]}; }
    LDS_WAIT(); asm volatile("" ::: "memory");
}
__device__ __forceinline__ void p0_prologue(Frame& F) {
    LAS float* L = (LAS float*)(F.lds + RING_OFF);
    const int tid = F.tid, lane = F.lane, wave = F.wave;
    for (int it = blockIdx.x; it < 448; it += F.G) {
        if (it < 192) {
            LAS float* sc = L;
            LAS float* red = L + 8192;
            for (int e = tid; e < 8192; e += 512) { const float v = F.c[e]; sc[e] = v / (1.0f + __expf(-v)); }
            __syncthreads();
            const int j0 = 32 * it, col = lane & 31, ksub = lane >> 5;
            float acc[8];
#pragma unroll
            for (int b = 0; b < 8; ++b) acc[b] = 0.f;
            for (int i = 0; i < 64; ++i) { const int k = 128 * wave + 2 * i + ksub; const float wv = F.w_ada[(size_t)k * 6144 + j0 + col];
#pragma unroll
                for (int b = 0; b < 8; ++b) acc[b] += sc[b * 1024 + k] * wv; }
#pragma unroll
            for (int b = 0; b < 8; ++b) red[((wave * 2 + ksub) * 8 + b) * 32 + col] = acc[b];
            __syncthreads();
            if (tid < 256) { const int b = tid >> 5, cc = tid & 31; float s = F.b_ada[j0 + cc];
#pragma unroll
                for (int p = 0; p < 16; ++p) s += red[(p * 8 + b) * 32 + cc];
                F.MOD[b * 6144 + j0 + cc] = s; }
            __syncthreads();
        } else if (it < 320) {
            const int f = it - 192, h = f >> 4, k0 = 64 * (f & 15);
            LAS float* win_s = L;
            LAS float* wuk_s = L + 64 * 65;
            for (int e = tid; e < 4096; e += 512) { const int kk = e >> 6, d = e & 63; win_s[kk * 65 + d] = F.w_in[(size_t)(k0 + kk) * DIN + 1536 + h * 64 + d]; }
            for (int e = tid; e < 8192; e += 512) wuk_s[e] = F.w_uk[(size_t)h * 8192 + e];
            __syncthreads();
            const int kk = tid & 63, r0 = 16 * (tid >> 6);
            float acc[16];
#pragma unroll
            for (int i = 0; i < 16; ++i) acc[i] = 0.f;
            for (int d = 0; d < 64; ++d) { const float a = win_s[kk * 65 + d];
#pragma unroll
                for (int i = 0; i < 16; ++i) acc[i] += a * wuk_s[d * 128 + r0 + i]; }
#pragma unroll
            for (int i = 0; i < 16; ++i) F.WIN[(size_t)(C_QL + h * 128 + r0 + i) * D + k0 + kk] = (bf16)f2bf(acc[i]);
            __syncthreads();
        } else {
            const int f = it - 320, h = f >> 4, n0 = 64 * (f & 15);
            LAS float* wuv_s = L;
            LAS float* wo_s = L + 128 * 65;
            for (int e = tid; e < 8192; e += 512) { const int r = e >> 6, d = e & 63; wuv_s[r * 65 + d] = F.w_uv[(size_t)h * 8192 + e]; }
            for (int e = tid; e < 4096; e += 512) { const int d = e >> 6, nn = e & 63; wo_s[e] = F.w_out[(size_t)(512 + h * 64 + d) * D + n0 + nn]; }
            __syncthreads();
            const int r = tid & 127, nn0 = 16 * (tid >> 7);
            float acc[16];
#pragma unroll
            for (int i = 0; i < 16; ++i) acc[i] = 0.f;
            for (int d = 0; d < 64; ++d) { const float a = wuv_s[r * 65 + d];
#pragma unroll
                for (int i = 0; i < 16; ++i) acc[i] += a * wo_s[d * 64 + nn0 + i]; }
#pragma unroll
            for (int i = 0; i < 16; ++i) F.WOUT[(size_t)(n0 + nn0 + i) * KOUT + 512 + h * 128 + r] = (bf16)f2bf(acc[i]);
            __syncthreads();
        }
    }
    __syncthreads();
    LAS float* scr = (LAS float*)(F.lds + RING_OFF + wave * 16384);
    const int gw = blockIdx.x * NWAVES + wave, NGW = F.G * NWAVES;
    constexpr int J1 = 16 * 48, J2 = 16 * 23, J4 = 8 * 32, J5 = 16 * 176, J6 = 44 * 32;
    for (int it = gw; it < J1 + J2 + J4 + J5 + J6; it += NGW) {
        int r = it;
        if (r < J1) { const int kb = r / 48, nb = r % 48; tr_item(F.w_in, DIN, 64 * kb, 32 * nb, 32, F.WIN, D, 32 * nb, scr, lane); continue; } r -= J1;
        if (r < J2) { const int kb = r / 23, nb = r % 23; const int n0 = 2048 + 32 * nb; const int nv = (DIN - n0) < 32 ? (DIN - n0) : 32; tr_item(F.w_in, DIN, 64 * kb, n0, nv, F.WIN, D, n0 + 512, scr, lane); continue; } r -= J2;
        if (r < J4) { const int kb = r / 32, nb = r % 32; tr_item(F.w_out, D, 64 * kb, 32 * nb, 32, F.WOUT, KOUT, 32 * nb, scr, lane); continue; } r -= J4;
        if (r < J5) { const int kb = r / 176, nb = r % 176; const int n0 = 32 * nb; const int isup = n0 >= DFF ? 1 : 0; const int u0 = n0 - isup * DFF; const int drow = (u0 >> 7) * 256 + isup * 128 + (u0 & 127);
            if (FFN_FP8) tr_item8(F.w_gu, NGU, 64 * kb, n0, (unsigned char*)F.WGU, D, drow, W8_SCALE, scr, lane); else tr_item(F.w_gu, NGU, 64 * kb, n0, 32, F.WGU, D, drow, scr, lane); continue; } r -= J5;
        { const int kb = r / 32, nb = r % 32; if (FFN_FP8) tr_item8(F.w_down, D, 64 * kb, 32 * nb, (unsigned char*)F.WDN, DFF, 32 * nb, W8_SCALE, scr, lane); else tr_item(F.w_down, D, 64 * kb, 32 * nb, 32, F.WDN, DFF, 32 * nb, scr, lane); }
    }
    { const int gt = blockIdx.x * 512 + tid; const int nchunk = (NPROJ - C_END) * D / 8;
      for (int e = gt; e < nchunk; e += F.G * 512) *(GAS v4u*)(F.WIN + (size_t)C_END * D + (size_t)e * 8) = (v4u){0u, 0u, 0u, 0u}; }
}

__device__ __forceinline__ void modnorm_rows(Frame& F, const float* X, const float* g, int sc_chunk, int sh_chunk, bf16* out) {
    const int gw = blockIdx.x * NWAVES + F.wave, NGW = F.G * NWAVES;
    for (int m = gw; m < M; m += NGW) {
        const int b = m >> 12;
        const GAS f32x4* xr = (const GAS f32x4*)(X + (size_t)m * D) + F.lane;
        const GAS f32x4* gr = (const GAS f32x4*)g + F.lane;
        const GAS f32x4* scr = (const GAS f32x4*)(F.MOD + b * 6144 + sc_chunk * 1024) + F.lane;
        const GAS f32x4* shr = (const GAS f32x4*)(F.MOD + b * 6144 + sh_chunk * 1024) + F.lane;
        f32x4 v[4]; float s = 0.f;
#pragma unroll
        for (int j = 0; j < 4; ++j) { v[j] = xr[64 * j]; s += (v[j].x * v[j].x + v[j].y * v[j].y) + (v[j].z * v[j].z + v[j].w * v[j].w); }
        const float rstd = 1.0f / sqrtf(wave_sum(s) * (1.f / D) + EPS);
        GAS unsigned long long* o8 = (GAS unsigned long long*)(out + (size_t)m * D) + F.lane;
#pragma unroll
        for (int j = 0; j < 4; ++j) { const f32x4 gg = gr[64 * j], sc = scr[64 * j], sh = shr[64 * j];
            const f32x4 y = v[j] * rstd * gg * (sc + 1.0f) + sh;
            o8[64 * j] = (unsigned long long)pkbf(y.x, y.y) | ((unsigned long long)pkbf(y.z, y.w) << 32); }
    }
}
__device__ __forceinline__ void modnorm_rows8(Frame& F, const float* X, const float* g, int sc_chunk, int sh_chunk, unsigned char* out, float oscale) {
    const int gw = blockIdx.x * NWAVES + F.wave, NGW = F.G * NWAVES;
    for (int m = gw; m < M; m += NGW) {
        const int b = m >> 12;
        const GAS f32x4* xr = (const GAS f32x4*)(X + (size_t)m * D) + F.lane;
        const GAS f32x4* gr = (const GAS f32x4*)g + F.lane;
        const GAS f32x4* scr = (const GAS f32x4*)(F.MOD + b * 6144 + sc_chunk * 1024) + F.lane;
        const GAS f32x4* shr = (const GAS f32x4*)(F.MOD + b * 6144 + sh_chunk * 1024) + F.lane;
        f32x4 v[4]; float s = 0.f;
#pragma unroll
        for (int j = 0; j < 4; ++j) { v[j] = xr[64 * j]; s += (v[j].x * v[j].x + v[j].y * v[j].y) + (v[j].z * v[j].z + v[j].w * v[j].w); }
        const float rstd = 1.0f / sqrtf(wave_sum(s) * (1.f / D) + EPS);
        GAS int* o4 = (GAS int*)(out + (size_t)m * D) + F.lane;
#pragma unroll
        for (int j = 0; j < 4; ++j) { const f32x4 gg = gr[64 * j], sc = scr[64 * j], sh = shr[64 * j];
            const f32x4 y = (v[j] * rstd * gg * (sc + 1.0f) + sh) * oscale;
            int w = __builtin_amdgcn_cvt_pk_fp8_f32(y.x, y.y, 0, false); w = __builtin_amdgcn_cvt_pk_fp8_f32(y.z, y.w, w, true);
            o4[64 * j] = w; }
    }
}
__device__ __forceinline__ void final_norm_rows(Frame& F) {
    const int gw = blockIdx.x * NWAVES + F.wave, NGW = F.G * NWAVES;
    for (int m = gw; m < M; m += NGW) {
        GAS f32x4* xr = (GAS f32x4*)(F.out + (size_t)m * D) + F.lane;
        const GAS f32x4* gr = (const GAS f32x4*)F.g_final + F.lane;
        f32x4 v[4]; float s = 0.f;
#pragma unroll
        for (int j = 0; j < 4; ++j) { v[j] = xr[64 * j]; s += (v[j].x * v[j].x + v[j].y * v[j].y) + (v[j].z * v[j].z + v[j].w * v[j].w); }
        const float rstd = 1.0f / sqrtf(wave_sum(s) * (1.f / D) + EPS);
#pragma unroll
        for (int j = 0; j < 4; ++j) xr[64 * j] = v[j] * rstd * gr[64 * j];
    }
}
__device__ __forceinline__ void ckv_norm_rows(Frame& F) {
    const int gw = blockIdx.x * NWAVES + F.wave, NGW = F.G * NWAVES;
    const int sub = F.lane >> 4, c8 = (F.lane & 15) * 8;
    f32x4 g0 = *(const GAS f32x4*)(F.kv_g + c8), g1 = *(const GAS f32x4*)(F.kv_g + c8 + 4);
    for (int it = gw; it < M / 4; it += NGW) {
        const int m = 4 * it + sub;
        const v4u w = *(const GAS v4u*)(F.PROJ + (size_t)m * NPROJ + C_CKV + c8);
        float v[8] = {bflo(w.x), bfhi(w.x), bflo(w.y), bfhi(w.y), bflo(w.z), bfhi(w.z), bflo(w.w), bfhi(w.w)};
        float s = 0.f;
#pragma unroll
        for (int j = 0; j < 8; ++j) s += v[j] * v[j];
        s += __shfl_xor(s, 1); s += __shfl_xor(s, 2); s += __shfl_xor(s, 4); s += __shfl_xor(s, 8);
        const float rstd = 1.0f / sqrtf(s * (1.f / 128.f) + EPS);
        v4u o; o.x = pkbf(v[0] * rstd * g0.x, v[1] * rstd * g0.y); o.y = pkbf(v[2] * rstd * g0.z, v[3] * rstd * g0.w);
        o.z = pkbf(v[4] * rstd * g1.x, v[5] * rstd * g1.y); o.w = pkbf(v[6] * rstd * g1.z, v[7] * rstd * g1.w);
        *(GAS v4u*)(F.CKVN + (size_t)m * 128 + c8) = o;
    }
}
namespace ga {
constexpr int VROW = 192;
constexpr int VTILE = 32 * VROW;
__device__ __forceinline__ int crow(int reg, int hi) { return (reg & 3) + 8 * (reg >> 2) + 4 * hi; }
struct TileP { int d, g, tok0, jb; };
__device__ __forceinline__ TileP tile_params(int n, int T0, int r) {
    TileP p;
    if (n < 5) { p.d = 16; p.g = 1; p.tok0 = T0 + r + 16 * (-128 + 32 * n); p.jb = 128 - 32 * n; }
    else if (n < 13) { const int a = n - 5; p.d = 4; p.g = 4; p.tok0 = T0 + (r & 3) + 4 * ((r >> 2) - 128 + 32 * a); p.jb = 128 - 32 * a; }
    else { const int a = n - 13; p.d = 1; p.g = 16; p.tok0 = T0 + r - 128 + 32 * a; p.jb = 128 - 32 * a; }
    return p;
}
__device__ __forceinline__ void unit(int b, int h, int rng, const bf16* PROJ, bf16* MIX, LAS unsigned char* vt, int lane, int wave) {
    const int qi = lane & 31, hi = lane >> 5;
    const int T0 = rng * 512;
    const size_t rowbase = (size_t)b * T;
    const float slope = exp2f(-0.5f * (float)(2 * h + 1));
    const float sl2 = slope * LOG2E, c2 = 0.125f * LOG2E;
    const int blk = (lane >> 4) & 1, q4 = (lane & 15) >> 2, p4 = lane & 3;
    for (int rs = 0; rs < 2; ++rs) {
        const int r = 2 * wave + rs;
        const int tq = T0 + r + 16 * qi;
        bf16x8 qf[4];
#pragma unroll
        for (int s = 0; s < 4; ++s) qf[s] = *(const GAS bf16x8*)(PROJ + (rowbase + tq) * NPROJ + C_QA + h * 64 + 16 * s + 8 * hi);
        float mrun = -1e30f, lsum = 0.f;
        f32x16 o0 = {}, o1 = {};
        bf16x8 kn[4], vn[4];
        { const TileP p = tile_params(0, T0, r); int tok = p.tok0 + p.d * qi; tok = tok < 0 ? 0 : tok;
          const bf16* kp = PROJ + (rowbase + tok) * NPROJ + h * 64 + 8 * hi;
#pragma unroll
          for (int s = 0; s < 4; ++s) { kn[s] = *(const GAS bf16x8*)(kp + C_KA + 16 * s); vn[s] = *(const GAS bf16x8*)(kp + C_VA + 16 * s); } }
        for (int n = 0; n < 33; ++n) {
            const TileP p = tile_params(n, T0, r);
            bf16x8 kf[4], vf[4];
#pragma unroll
            for (int s = 0; s < 4; ++s) { kf[s] = kn[s]; vf[s] = vn[s]; }
            if (n + 1 < 33) { const TileP pn = tile_params(n + 1, T0, r); int tok = pn.tok0 + pn.d * qi; tok = tok < 0 ? 0 : tok;
                const bf16* kp = PROJ + (rowbase + tok) * NPROJ + h * 64 + 8 * hi;
#pragma unroll
                for (int s = 0; s < 4; ++s) { kn[s] = *(const GAS bf16x8*)(kp + C_KA + 16 * s); vn[s] = *(const GAS bf16x8*)(kp + C_VA + 16 * s); } }
            if (p.tok0 + p.d * 31 < 0) continue;
#pragma unroll
            for (int s = 0; s < 4; ++s) *(LAS bf16x8*)(vt + qi * VROW + 32 * s + 16 * hi) = vf[s];
            f32x16 sacc = {};
#pragma unroll
            for (int s = 0; s < 4; ++s) sacc = __builtin_amdgcn_mfma_f32_32x32x16_bf16(kf[s], qf[s], sacc, 0, 0, 0);
            const int jl = p.g * qi + p.jb - 4 * hi;
            const int mmin = (p.tok0 < 0) ? ((-p.tok0 + p.d - 1) / p.d) : 0;
            const float sd = sl2 * (float)p.d;
            float sv[16]; float mx = -1e30f;
#pragma unroll
            for (int reg = 0; reg < 16; ++reg) { const int mo = (reg & 3) + 8 * (reg >> 2); const int j = jl - mo; const bool ok = (j >= 0) && (j <= 128) && (mo + 4 * hi >= mmin);
                const float v = ok ? (sacc[reg] * c2 - sd * (float)j) : -1e30f; sv[reg] = v; mx = fmaxf(mx, v); }
            mx = swap32_max(mx);
            const float mnew = fmaxf(mrun, mx);
            const float alpha = ex2(mrun - mnew);
            mrun = mnew;
            float ps = 0.f; float pv[16];
#pragma unroll
            for (int reg = 0; reg < 16; ++reg) { const float pe = (sv[reg] > -1e29f) ? ex2(sv[reg] - mnew) : 0.f; pv[reg] = pe; ps += pe; }
            lsum = lsum * alpha + ps;
            o0 *= alpha; o1 *= alpha;
            v4u pb0, pb1;
            pb0.x = pkbf(pv[0], pv[1]); pb0.y = pkbf(pv[2], pv[3]); pb0.z = pkbf(pv[4], pv[5]); pb0.w = pkbf(pv[6], pv[7]);
            pb1.x = pkbf(pv[8], pv[9]); pb1.y = pkbf(pv[10], pv[11]); pb1.z = pkbf(pv[12], pv[13]); pb1.w = pkbf(pv[14], pv[15]);
            LDS_WAIT();
#pragma unroll
            for (int s = 0; s < 2; ++s) {
                const bf16x8 pb = __builtin_bit_cast(bf16x8, s == 0 ? pb0 : pb1);
#pragma unroll
                for (int mt = 0; mt < 2; ++mt) {
                    const LAS unsigned char* a0 = vt + (16 * s + 4 * hi + q4) * VROW + (32 * mt + 16 * blk + 4 * p4) * 2;
                    const s16x4 lo = tr16(a0), hi4 = tr16(a0 + 8 * VROW);
                    const bf16x8 va = {lo[0], lo[1], lo[2], lo[3], hi4[0], hi4[1], hi4[2], hi4[3]};
                    if (mt == 0) o0 = __builtin_amdgcn_mfma_f32_32x32x16_bf16(va, pb, o0, 0, 0, 0);
                    else o1 = __builtin_amdgcn_mfma_f32_32x32x16_bf16(va, pb, o1, 0, 0, 0);
                }
            }
            LDS_WAIT();
        }
        const float linv = 1.0f / swap32_sum(lsum);
        bf16* op = MIX + (rowbase + tq) * KOUT + h * 64 + 4 * hi;
#pragma unroll
        for (int mt = 0; mt < 2; ++mt)
#pragma unroll
            for (int gq = 0; gq < 4; ++gq) { const f32x16& o = mt == 0 ? o0 : o1;
                u32x2 w; w.x = pkbf(o[4 * gq] * linv, o[4 * gq + 1] * linv); w.y = pkbf(o[4 * gq + 2] * linv, o[4 * gq + 3] * linv);
                *(GAS u32x2*)(op + 32 * mt + 8 * gq) = w; }
    }
}
}
#ifndef TKP
#define TKP 0
#endif
namespace tk {
constexpr int CAP = 632;
constexpr int WSCR = 3072;
__device__ __forceinline__ unsigned mono16(float sc) { const _Float16 hf = (_Float16)sc; const unsigned h = (unsigned)__builtin_bit_cast(unsigned short, hf); return (h ^ ((h & 0x8000u) ? 0xFFFFu : 0x8000u)) & 0xFFFFu; }
__device__ __forceinline__ float relu(float x) { const int b = __float_as_int(x); return __int_as_float(b > 0 ? b : 0); }
template <bool MASKED, int MT0, unsigned INCM>
__device__ __forceinline__ void tile_scores(const f32x16 (&X)[1], int key, int QT0, LAS unsigned* HIST, const LAS unsigned* EX, unsigned (&kout)[8], int hk) {
#pragma unroll
    for (int m2 = 0; m2 < 1; ++m2) { const int mt = MT0 + m2;
        asm volatile("" ::: "memory");
#pragma unroll
        for (int be = 0; be < 2; ++be) {
            const int qq = 4 * mt + 2 * hk + be;
            const LAS f32x4* wp = (const LAS f32x4*)(EX + 8 * qq);
            const f32x4 wa = wp[0], wb = wp[1];
            float sc = 0.f;
            sc = fmaf(wa[0], relu(X[m2][8 * be + 0]), sc); sc = fmaf(wa[1], relu(X[m2][8 * be + 1]), sc);
            sc = fmaf(wa[2], relu(X[m2][8 * be + 2]), sc); sc = fmaf(wa[3], relu(X[m2][8 * be + 3]), sc);
            sc = fmaf(wb[0], relu(X[m2][8 * be + 4]), sc); sc = fmaf(wb[1], relu(X[m2][8 * be + 5]), sc);
            sc = fmaf(wb[2], relu(X[m2][8 * be + 6]), sc); sc = fmaf(wb[3], relu(X[m2][8 * be + 7]), sc);
            const unsigned k16 = mono16(sc);
            kout[2 * mt + be] = k16;
            if (!MASKED || key <= QT0 + qq)
                __hip_atomic_fetch_add(HIST + qq * 2048 + ((k16 >> 4) & 2047u), ((k16 >> 15) ? 65536u : 1u) * INCM, __ATOMIC_RELAXED, __HIP_MEMORY_SCOPE_WORKGROUP);
        }
    }
}
__device__ __forceinline__ void store_keys(const unsigned (&kv)[8], int key, __amdgpu_buffer_rsrc_t scr, int hk) {
#pragma unroll
    for (int mt = 0; mt < 4; ++mt) __builtin_amdgcn_raw_buffer_store_b32(kv[2 * mt] | (kv[2 * mt + 1] << 16), scr, (key << 2) + (hk << 14), mt << 15, 0);
}
__device__ __forceinline__ unsigned prefix_scan(unsigned v) {
    v += (unsigned)__builtin_amdgcn_update_dpp(0, (int)v, 0x111, 0xf, 0xf, false);
    v += (unsigned)__builtin_amdgcn_update_dpp(0, (int)v, 0x112, 0xf, 0xf, false);
    v += (unsigned)__builtin_amdgcn_update_dpp(0, (int)v, 0x114, 0xf, 0xf, false);
    v += (unsigned)__builtin_amdgcn_update_dpp(0, (int)v, 0x118, 0xf, 0xf, false);
    v += (unsigned)__builtin_amdgcn_update_dpp(0, (int)v, 0x142, 0xa, 0xf, false);
    v += (unsigned)__builtin_amdgcn_update_dpp(0, (int)v, 0x143, 0xc, 0xf, false);
    return v;
}
__device__ __forceinline__ unsigned rdlane(unsigned v, int l) { return (unsigned)__builtin_amdgcn_readlane((int)v, l); }
__device__ __forceinline__ unsigned mbcnt64(unsigned long long m) { return __builtin_amdgcn_mbcnt_hi((unsigned)(m >> 32), __builtin_amdgcn_mbcnt_lo((unsigned)m, 0u)); }
__device__ __forceinline__ void zero_hist(LAS unsigned char* lds, int tid) {
    for (int e = tid; e < 16 * 2048 / 4; e += 512) ((LAS v4u*)lds)[e] = (v4u){0u, 0u, 0u, 0u};
}
template <unsigned INCM>
__device__ __forceinline__ void pass_a(const bf16* PROJ, size_t rowbase, int QT0, int nkt, LAS unsigned* HIST, const LAS unsigned* EX, __amdgpu_buffer_rsrc_t scr, const bf16x8 (&qf)[4][4], int kc, int hk, int wave) {
    {
        bf16x8 kn[4];
        if (wave < nkt) { const bf16* kp = PROJ + (rowbase + 32 * wave + kc) * NPROJ + C_KI + 8 * hk;
#pragma unroll
            for (int s = 0; s < 4; ++s) kn[s] = *(const GAS bf16x8*)(kp + 16 * s); }
        unsigned pend[8]; int pkey = -1;
#pragma unroll
        for (int i = 0; i < 8; ++i) pend[i] = 0u;
        for (int kt = wave; kt < nkt; kt += NWAVES) {
            bf16x8 kf[4];
#pragma unroll
            for (int s = 0; s < 4; ++s) kf[s] = kn[s];
            if (kt + NWAVES < nkt) { const bf16* kp = PROJ + (rowbase + 32 * (kt + NWAVES) + kc) * NPROJ + C_KI + 8 * hk;
#pragma unroll
                for (int s = 0; s < 4; ++s) kn[s] = *(const GAS bf16x8*)(kp + 16 * s); }
            if (pkey >= 0) store_keys(pend, pkey, scr, hk);
            const int key = 32 * kt + kc;
            const bool lastt = (kt == nkt - 1);
#pragma unroll
            for (int hf = 0; hf < 4; ++hf) {
                f32x16 X[1];
                X[0] = (f32x16){};
#pragma unroll
                for (int s = 0; s < 4; ++s) X[0] = __builtin_amdgcn_mfma_f32_32x32x16_bf16(qf[hf][s], kf[s], X[0], 0, 0, 0);
                if (hf == 0) { if (lastt) tile_scores<true, 0, INCM>(X, key, QT0, HIST, EX, pend, hk); else tile_scores<false, 0, INCM>(X, key, QT0, HIST, EX, pend, hk); }
                else if (hf == 1) { if (lastt) tile_scores<true, 1, INCM>(X, key, QT0, HIST, EX, pend, hk); else tile_scores<false, 1, INCM>(X, key, QT0, HIST, EX, pend, hk); }
                else if (hf == 2) { if (lastt) tile_scores<true, 2, INCM>(X, key, QT0, HIST, EX, pend, hk); else tile_scores<false, 2, INCM>(X, key, QT0, HIST, EX, pend, hk); }
                else { if (lastt) tile_scores<true, 3, INCM>(X, key, QT0, HIST, EX, pend, hk); else tile_scores<false, 3, INCM>(X, key, QT0, HIST, EX, pend, hk); }
            }
            pkey = key;
        }
        if (pkey >= 0) store_keys(pend, pkey, scr, hk);
    }
}
__device__ __forceinline__ void unit(int b, int qt, const bf16* PROJ, unsigned short* IDX, unsigned* SCw, LAS unsigned char* lds, LAS unsigned* EX, gu32* errw, int tid_in, int lane_in, int wave) {
    int tid = tid_in, lane = lane_in; asm volatile("" : "+v"(tid), "+v"(lane));
    const int QT0 = 16 * qt;
    const size_t rowbase = (size_t)b * T;
    if (QT0 < TOPK) {
        const int qq = tid >> 5, j0 = (tid & 31) * 8, t = QT0 + qq;
        unsigned short v[8];
#pragma unroll
        for (int j = 0; j < 8; ++j) v[j] = (j0 + j <= t) ? (unsigned short)(j0 + j) : (unsigned short)0xFFFF;
        v4u w; w.x = v[0] | ((unsigned)v[1] << 16); w.y = v[2] | ((unsigned)v[3] << 16); w.z = v[4] | ((unsigned)v[5] << 16); w.w = v[6] | ((unsigned)v[7] << 16);
        *(GAS v4u*)(IDX + (rowbase + t) * 256 + j0) = w;
        return;
    }
    LAS unsigned* HIST = (LAS unsigned*)lds;
    LAS unsigned short* SEL = (LAS unsigned short*)((LAS unsigned char*)EX + 1024 + wave * WSCR);
    LAS unsigned* CAND = (LAS unsigned*)((LAS unsigned char*)EX + 1024 + wave * WSCR + 528);
    const int nkt = (QT0 + 16 + 31) >> 5;
    const int kc = lane & 31, hk = lane >> 5;
    bf16x8 qf[4][4];
    { const int rho = lane & 31; const int ql = (rho >> 4) + 2 * ((rho >> 2) & 1), hd = 4 * ((rho >> 3) & 1) + (rho & 3);
#pragma unroll
      for (int mt = 0; mt < 4; ++mt) { const bf16* qp = PROJ + (rowbase + QT0 + 4 * mt + ql) * NPROJ + C_QI + hd * 64 + 8 * hk;
#pragma unroll
          for (int s = 0; s < 4; ++s) qf[mt][s] = *(const GAS bf16x8*)(qp + 16 * s); } }
    if (tid < 128) { const int qq = tid >> 3, h = tid & 7; ((LAS float*)EX)[tid] = bf2f(PROJ[(rowbase + QT0 + qq) * NPROJ + C_WI + h]) * IDX_SCALE; }
    __syncthreads();
    const __amdgpu_buffer_rsrc_t scr = __builtin_amdgcn_make_buffer_rsrc(SCw, 0, 8 * 4096 * 4, 0x00020000);
    if (TKP & 1) pass_a<0u>(PROJ, rowbase, QT0, nkt, HIST, EX, scr, qf, kc, hk, wave);
    pass_a<1u>(PROJ, rowbase, QT0, nkt, HIST, EX, scr, qf, kc, hk, wave);
    VM_WAIT();
    __syncthreads();
    asm volatile("" : "+v"(lane));
    v4u rowv[16];
    { const int tmax = QT0 + 2 * wave + 1;
#pragma unroll
      for (int c = 0; c < 16; ++c) { rowv[c] = (v4u){0u, 0u, 0u, 0u}; if (256 * c <= tmax) rowv[c] = __builtin_bit_cast(v4u, __builtin_amdgcn_raw_buffer_load_b128(scr, lane * 16, wave * 16384 + c * 1024, 0)); } }
#pragma unroll 1
    for (int qs2 = ((TKP & 2) ? 0 : 2); qs2 < 4; ++qs2) {
        const int qs = qs2 & 1; const bool zero_it = qs2 >= 2;
        const int qq = 2 * wave + qs, t = QT0 + qq;
        const int ksh = 16 * qs;
        LAS unsigned* Hq = HIST + qq * 2048;
        const int wl = 32 * (63 - lane);
        unsigned chi = 0, clo = 0;
        #pragma unroll 8
        for (int i = 0; i < 32; ++i) { const unsigned w = Hq[wl + ((i + lane) & 31)]; chi += w >> 16; clo += w & 0xFFFFu; }
        const unsigned Phi = prefix_scan(chi), Plo = prefix_scan(clo);
        const unsigned Ptot = rdlane(Phi, 63), Ntot = rdlane(Plo, 63);
        const bool half = Ptot >= (unsigned)TOPK;
        const unsigned base0 = half ? 0u : Ptot;
        const unsigned P = half ? Phi : Plo, tot = half ? chi : clo;
        const unsigned long long mk = __ballot(base0 + P >= (unsigned)TOPK);
        const int ls = mk ? (int)__builtin_ctzll(mk) : 0;
        const unsigned above = base0 + rdlane(P, ls) - rdlane(tot, ls);
        const int ws = 32 * (63 - ls);
        const unsigned w2 = Hq[ws + 31 - (lane & 31)];
        const unsigned v2 = lane < 32 ? (half ? (w2 >> 16) : (w2 & 0xFFFFu)) : 0u;
        const unsigned P2 = prefix_scan(v2);
        const unsigned long long mk2 = __ballot(above + P2 >= (unsigned)TOPK) & 0xFFFFFFFFull;
        const int j = mk2 ? (int)__builtin_ctzll(mk2) : 0;
        const unsigned na = above + rdlane(P2, j) - rdlane(v2, j);
        const unsigned bstar = ((half ? 1u : 0u) << 11) | (unsigned)(ws + 31 - j);
        if (lane == 0 && (mk == 0ull || mk2 == 0ull || Ptot + Ntot != (unsigned)(t + 1))) __hip_atomic_store(errw, 1u, RLX_AGENT);
        LDS_WAIT(); asm volatile("" ::: "memory");
        if (zero_it)
#pragma unroll
        for (int i = 0; i < 8; ++i) *(LAS v4u*)(Hq + 32 * lane + 4 * ((i + (lane >> 1)) & 7)) = (v4u){0u, 0u, 0u, 0u};
        unsigned short* irow = IDX + (rowbase + t) * 256;
        unsigned selbase = 0, candbase = 0;
        const unsigned thr_hi = (bstar + 1u) << 4, thr_lo = bstar << 4;
#pragma unroll
        for (int g = 0; g < 4; ++g) {
            if (1024 * g <= t) {
                unsigned k16v[16]; unsigned cnt = 0u, ccnt = 0u;
#pragma unroll
                for (int c = 0; c < 4; ++c)
#pragma unroll
                    for (int e = 0; e < 4; ++e) { const int key = 1024 * g + 256 * c + 4 * lane + e; unsigned k16 = (rowv[4 * g + c][e] >> ksh) & 0xFFFFu;
                        bool in = true; if (1024 * g + 1023 > t) in = key <= t;
                        k16v[4 * c + e] = k16; cnt += (in && k16 >= thr_hi) ? 1u : 0u; ccnt += (in && k16 >= thr_lo && k16 < thr_hi) ? 1u : 0u; }
                const bool tailg = 1024 * g + 1023 > t;
                { const unsigned Pc = prefix_scan(cnt); unsigned pos = selbase + Pc - cnt; selbase += rdlane(Pc, 63);
#pragma unroll
                  for (int i = 0; i < 16; ++i) { const int key = 1024 * g + 256 * (i >> 2) + 4 * lane + (i & 3); bool ab = k16v[i] >= thr_hi; if (tailg) ab = ab && key <= t;
                      SEL[ab ? (pos < 256u ? pos : 256u) : 256u] = (unsigned short)key; pos += ab ? 1u : 0u; } }
                if (__ballot(ccnt != 0u)) { const unsigned Pc = prefix_scan(ccnt); unsigned pos = candbase + Pc - ccnt; candbase += rdlane(Pc, 63);
#pragma unroll
                  for (int i = 0; i < 16; ++i) { const int key = 1024 * g + 256 * (i >> 2) + 4 * lane + (i & 3); bool cd = k16v[i] >= thr_lo && k16v[i] < thr_hi; if (tailg) cd = cd && key <= t;
                      if (cd) { if (pos < (unsigned)CAP) CAND[pos] = ((k16v[i] & 0xFu) << 12) | (unsigned)(4095 - key); ++pos; } } }
            }
        }
        const unsigned need = (unsigned)TOPK - na;
        unsigned nc = candbase;
        if (lane == 0 && (selbase != na || nc < need || nc > (unsigned)CAP)) __hip_atomic_store(errw, 2u, RLX_AGENT);
        nc = nc > (unsigned)CAP ? (unsigned)CAP : nc;
        LDS_WAIT(); asm volatile("" ::: "memory");
        if (lane < 4) CAND[nc + lane] = 0u;
        LDS_WAIT(); asm volatile("" ::: "memory");
        const int ns = (int)((nc + 63u) >> 6);
        unsigned cvs[10], rks[10];
#pragma unroll
        for (int sl = 0; sl < 10; ++sl) { cvs[sl] = 0xFFFFFFFFu; rks[sl] = 0u; if (sl < ns) { const unsigned i = lane + 64u * sl; if (i < nc) cvs[sl] = CAND[i]; } }
        for (unsigned jj = 0; jj < nc; jj += 4) { const v4u c4 = *(const LAS v4u*)(CAND + jj);
#pragma unroll
            for (int sl = 0; sl < 10; ++sl) if (sl < ns) rks[sl] += (c4.x > cvs[sl] ? 1u : 0u) + (c4.y > cvs[sl] ? 1u : 0u) + (c4.z > cvs[sl] ? 1u : 0u) + (c4.w > cvs[sl] ? 1u : 0u); }
#pragma unroll
        for (int sl = 0; sl < 10; ++sl) if (sl < ns) { const unsigned i = lane + 64u * sl; if (i < nc && rks[sl] < need) SEL[na + rks[sl]] = (unsigned short)(4095u - (cvs[sl] & 0xFFFu)); }
        LDS_WAIT(); asm volatile("" ::: "memory");
        if (lane < 32) { const v4u w = *(const LAS v4u*)(SEL + lane * 8); *(GAS v4u*)(irow + lane * 8) = w; }
        LDS_WAIT(); asm volatile("" ::: "memory");
    }
}
}
namespace sp {
constexpr int IMG_BYTES = 8192, IDXL_BYTES = 512, WAVE_BYTES = IMG_BYTES + IDXL_BYTES;
__device__ __forceinline__ unsigned off_b(unsigned row, unsigned ch) { return 256u * row + 16u * (ch ^ (((row & 3u) << 2) | ((row >> 2) & 3u))); }
__device__ __forceinline__ void query(int m  , const bf16* PROJ, const bf16* CKVN, const unsigned short* IDX, bf16* MIX, LAS unsigned char* wl, int lane) {
    LAS unsigned char* img = wl; LAS unsigned short* idl = (LAS unsigned short*)(wl + IMG_BYTES);
    const int b = m >> 12, t = m & 4095;
    const int hd = lane & 15, g = lane >> 4;
    const bf16* cb = CKVN + (size_t)b * T * 128;
    { const u32x2 w = *(const GAS u32x2*)(IDX + (size_t)m * 256 + 4 * lane); *(LAS u32x2*)(idl + 4 * lane) = w; }
    bf16x8 qf[4];
#pragma unroll
    for (int s = 0; s < 4; ++s) { bf16x8 z = {}; qf[s] = hd < 8 ? *(const GAS bf16x8*)(PROJ + (size_t)m * NPROJ + C_QL + hd * 128 + 32 * s + 8 * g) : z; }
    const float slope = exp2f(-(float)((hd & 7) + 1));
    const float sl2 = slope * LOG2E, c2 = 0.125f * LOG2E;
    float mrun = -1e30f, lsum = 0.f;
    f32x4 o[8];
#pragma unroll
    for (int i = 0; i < 8; ++i) o[i] = (f32x4){0.f, 0.f, 0.f, 0.f};
    LDS_WAIT();
    const int q4 = (lane & 15) >> 2, p4 = lane & 3;
    bf16x8 gn[8];
#pragma unroll
    for (int i = 0; i < 8; ++i) { const int n = lane + 64 * i, row = n >> 4, ch = n & 15; unsigned id = idl[row]; id = id == 0xFFFFu ? 0u : id; gn[i] = *(const GAS bf16x8*)(cb + (size_t)id * 128 + ch * 8); }
    for (int c = 0; c < 8; ++c) {
#pragma unroll
        for (int i = 0; i < 8; ++i) { const int n = lane + 64 * i, row = n >> 4, ch = n & 15; *(LAS bf16x8*)(img + off_b(row, ch)) = gn[i]; }
        if (c + 1 < 8) {
#pragma unroll
            for (int i = 0; i < 8; ++i) { const int n = lane + 64 * i, row = n >> 4, ch = n & 15; unsigned id = idl[32 * (c + 1) + row]; id = id == 0xFFFFu ? 0u : id; gn[i] = *(const GAS bf16x8*)(cb + (size_t)id * 128 + ch * 8); }
        }
        LDS_WAIT();
        float sv[8]; float mx = -1e30f;
#pragma unroll
        for (int rb = 0; rb < 2; ++rb) {
            f32x4 acc = {0.f, 0.f, 0.f, 0.f};
#pragma unroll
            for (int s = 0; s < 4; ++s) { const bf16x8 a = *(const LAS bf16x8*)(img + off_b((lane & 15) + 16 * rb, 4 * s + g)); acc = __builtin_amdgcn_mfma_f32_16x16x32_bf16(a, qf[s], acc, 0, 0, 0); }
            const u32x2 iw = *(const LAS u32x2*)(idl + 32 * c + 16 * rb + 4 * g);
            const unsigned ids[4] = {iw.x & 0xFFFFu, iw.x >> 16, iw.y & 0xFFFFu, iw.y >> 16};
#pragma unroll
            for (int e = 0; e < 4; ++e) { const bool ok = ids[e] != 0xFFFFu; const float v = ok ? (acc[e] * c2 - sl2 * (float)(t - (int)ids[e])) : -1e30f; sv[4 * rb + e] = v; mx = fmaxf(mx, v); }
        }
        mx = fmaxf(mx, __shfl_xor(mx, 16)); mx = fmaxf(mx, __shfl_xor(mx, 32));
        const float mnew = fmaxf(mrun, mx);
        const float alpha = ex2(mrun - mnew);
        mrun = mnew;
        float pv[8]; float ps = 0.f;
#pragma unroll
        for (int e = 0; e < 8; ++e) { const float pe = (sv[e] > -1e29f) ? ex2(sv[e] - mnew) : 0.f; pv[e] = pe; ps += pe; }
        lsum = lsum * alpha + ps;
        v4u pw; pw.x = pkbf(pv[0], pv[1]); pw.y = pkbf(pv[2], pv[3]); pw.z = pkbf(pv[4], pv[5]); pw.w = pkbf(pv[6], pv[7]);
        const bf16x8 pb = __builtin_bit_cast(bf16x8, pw);
#pragma unroll
        for (int mt = 0; mt < 8; ++mt) {
            const s16x4 lo = tr16(img + off_b(4 * g + q4, 2 * mt + (p4 >> 1)) + 8 * (p4 & 1));
            const s16x4 hi4 = tr16(img + off_b(16 + 4 * g + q4, 2 * mt + (p4 >> 1)) + 8 * (p4 & 1));
            const bf16x8 a = {lo[0], lo[1], lo[2], lo[3], hi4[0], hi4[1], hi4[2], hi4[3]};
            o[mt] = o[mt] * alpha;
            o[mt] = __builtin_amdgcn_mfma_f32_16x16x32_bf16(a, pb, o[mt], 0, 0, 0);
        }
        LDS_WAIT();
    }
    lsum += __shfl_xor(lsum, 16); lsum += __shfl_xor(lsum, 32);
    const float linv = 1.0f / lsum;
    if (hd < 8) {
        bf16* op = MIX + (size_t)m * KOUT + 512 + hd * 128 + 4 * g;
#pragma unroll
        for (int mt = 0; mt < 8; ++mt) { u32x2 w; w.x = pkbf(o[mt][0] * linv, o[mt][1] * linv); w.y = pkbf(o[mt][2] * linv, o[mt][3] * linv); *(GAS u32x2*)(op + 16 * mt) = w; }
    }
}
}
#ifndef DUP_MASK
#define DUP_MASK 0
#endif
struct Args { const float* in[14]; float* out; unsigned char* ws; int ph_lo, ph_hi; };
__global__ void __launch_bounds__(NWAVES * 64, 2) fwd(Args args) {
    extern __shared__ __attribute__((aligned(16))) unsigned char lds[];
    Frame F;
    F.lds = (LAS unsigned char*)lds;
    F.MISC = (volatile LAS unsigned*)(F.lds + MISC_OFF);
    F.tid = threadIdx.x; F.lane = F.tid & 63; F.wave = __builtin_amdgcn_readfirstlane(F.tid >> 6);
    F.G = gridDim.x;
    unsigned char* ws = args.ws;
    F.ctl = (gu32*)(ws + WS_CTL);
    F.x = args.in[0]; F.c = args.in[1]; F.w_ada = args.in[2]; F.b_ada = args.in[3]; F.g_attn = args.in[4]; F.w_in = args.in[5]; F.kv_g = args.in[6];
    F.w_uk = args.in[7]; F.w_uv = args.in[8]; F.w_out = args.in[9]; F.g_ffn = args.in[10]; F.w_gu = args.in[11]; F.w_down = args.in[12]; F.g_final = args.in[13];
    F.out = args.out;
    F.MOD = (float*)(ws + WS_MOD);
    F.WIN = (bf16*)(ws + WS_WIN); F.WOUT = (bf16*)(ws + WS_WOUT); F.WGU = (bf16*)(ws + WS_WGU); F.WDN = (bf16*)(ws + WS_WDN);
    F.CKVN = (bf16*)(ws + WS_CKVN); F.IDX = (unsigned short*)(ws + WS_IDX); F.XN = (bf16*)(ws + WS_XN); F.MIX = (bf16*)(ws + WS_MIX); F.PROJ = (bf16*)(ws + WS_PROJ); F.HB = (bf16*)(ws + WS_H);
    for (int u = F.tid; u < (LDS_BYTES - LDSCTL_OFF) / 4; u += NWAVES * 64) ((LAS unsigned*)(F.lds + LDSCTL_OFF))[u] = 0u;
    __syncthreads();
    XcdBarrier bar = xcd_barrier_post((unsigned*)(F.ctl + CW_BAR), F.MISC + 8);
    const int lo = args.ph_lo, hi = args.ph_hi;
#define IN(k) (lo <= (k) && (k) < hi)
#define BOTH(k) (IN(k) && IN((k) + 1))
#define GRID_BAR() xcd_barrier(bar)

    if (IN(0)) { p0_prologue(F); if (BOTH(0)) GRID_BAR(); }
    if (IN(1)) { modnorm_rows(F, F.x, F.g_attn, 1, 0, F.XN); if (BOTH(1)) GRID_BAR(); }
    if (IN(2)) {
        pg8::Gemm g{F.XN, F.WIN, M, NPROJ, D}; pg8::StaticOrder S; S.init(M, NPROJ, F.G, (int)blockIdx.x);
        pg8::EpiBf16<0> E{F.PROJ, NPROJ, nullptr, 0, 0, 1.f};
        pg8::gemm_phase<pg8::EpiBf16<0>, pg8::StaticOrder, true, true>(F.lds + RING_OFF, g, S, E);
        if (DUP_MASK & 8) { __syncthreads(); pg8::gemm_phase<pg8::EpiBf16<0>, pg8::StaticOrder, true, true>(F.lds + RING_OFF, g, S, E); }
        if (BOTH(2)) GRID_BAR();
    }
    if (IN(3)) {
        { int t_ = threadIdx.x; asm volatile("" : "+v"(t_)); F.tid = t_; F.lane = t_ & 63; }
        ckv_norm_rows(F);
        for (int rep = 0; rep < ((DUP_MASK & 1) ? 2 : 1); ++rep)
        for (int u = blockIdx.x; u < 512; u += F.G) ga::unit(u >> 6, (u >> 3) & 7, u & 7, F.PROJ, F.MIX, F.lds + RING_OFF + F.wave * ga::VTILE, F.lane, F.wave);
        __syncthreads();
        tk::zero_hist(F.lds + RING_OFF, F.tid);
        for (int rep = 0; rep < ((DUP_MASK & 2) ? 2 : 1); ++rep)
        for (int i = 0; i * F.G < 2048; ++i) { const int gp = (i & 1) ? (F.G - 1 - (int)blockIdx.x) : (int)blockIdx.x; const int L = i * F.G + gp;
            if (L < 2048) tk::unit(L & 7, L >> 3, F.PROJ, F.IDX, (unsigned*)F.XN + (size_t)blockIdx.x * 32768, F.lds + RING_OFF, (LAS unsigned*)(F.lds + EX_OFF), F.ctl + CW_ERR, F.tid, F.lane, F.wave); }
        if (BOTH(3)) GRID_BAR();
    }
    if (IN(4)) {
        { int t_ = threadIdx.x; asm volatile("" : "+v"(t_)); F.tid = t_; F.lane = t_ & 63; }
        const int gw = blockIdx.x * NWAVES + F.wave, NGW = F.G * NWAVES;
        for (int rep = 0; rep < ((DUP_MASK & 4) ? 2 : 1); ++rep)
        for (int m = gw; m < M; m += NGW) sp::query(m, F.PROJ, F.CKVN, F.IDX, F.MIX, F.lds + RING_OFF + F.wave * sp::WAVE_BYTES, F.lane);
        if (BOTH(4)) GRID_BAR();
    }
    if (IN(5)) {
        pg8::Gemm g{F.MIX, F.WOUT, M, D, KOUT}; pg8::StaticOrder S; S.init(M, D, F.G, (int)blockIdx.x);
        pg8::EpiGateRes E{F.x, F.out, D, F.MOD + 2 * 1024, 6144};
        pg8::gemm_phase<pg8::EpiGateRes, pg8::StaticOrder, true, true>(F.lds + RING_OFF, g, S, E);
        if (BOTH(5)) GRID_BAR();
    }
    if (IN(6)) { if (FFN_FP8) modnorm_rows8(F, F.out, F.g_ffn, 4, 3, (unsigned char*)F.XN, X8_SCALE); else modnorm_rows(F, F.out, F.g_ffn, 4, 3, F.XN); if (BOTH(6)) GRID_BAR(); }
    if (IN(7)) {
        if (FFN_FP8) {
            pg8::Gemm g{F.XN, F.WGU, M, NGU, D / 2, E8_W, E8_X}; pg8::StaticOrder S; S.init(M, NGU, F.G, (int)blockIdx.x);
            pg8::EpiSwiGLU8 E{(unsigned char*)F.HB, DFF, H8_SCALE};
            pg8::gemm_phase<pg8::EpiSwiGLU8, pg8::StaticOrder, true, true, true>(F.lds + RING_OFF, g, S, E);
        } else {
            pg8::Gemm g{F.XN, F.WGU, M, NGU, D}; pg8::StaticOrder S; S.init(M, NGU, F.G, (int)blockIdx.x);
            pg8::EpiSwiGLU E{F.HB, DFF};
            pg8::gemm_phase<pg8::EpiSwiGLU, pg8::StaticOrder, true, true>(F.lds + RING_OFF, g, S, E);
        }
        if (BOTH(7)) GRID_BAR();
    }
    if (IN(8)) {
        pg8::StaticOrder S; S.init(M, D, F.G, (int)blockIdx.x);
        pg8::EpiGateRes E{F.out, F.out, D, F.MOD + 5 * 1024, 6144};
        if (FFN_FP8) { pg8::Gemm g{F.HB, F.WDN, M, D, DFF / 2, E8_W, E8_H}; pg8::gemm_phase<pg8::EpiGateRes, pg8::StaticOrder, true, true, true>(F.lds + RING_OFF, g, S, E); }
        else { pg8::Gemm g{F.HB, F.WDN, M, D, DFF}; pg8::gemm_phase<pg8::EpiGateRes, pg8::StaticOrder, true, true>(F.lds + RING_OFF, g, S, E); }
        if (BOTH(8)) GRID_BAR();
    }
    if (IN(9)) {
        final_norm_rows(F);
        const unsigned bad = __hip_atomic_load(F.ctl + CW_ERR, RLX_AGENT) | __hip_atomic_load((gu32*)((unsigned*)(F.ctl + CW_BAR) + XB_TMO), RLX_AGENT);
        if (bad != 0u && blockIdx.x == 0 && F.tid < 64) F.out[F.tid] = __builtin_nanf("");
    }
#undef IN
#undef BOTH
#undef GRID_BAR
}

#ifndef MK_N_LAUNCHES
#define MK_N_LAUNCHES 1
#endif
extern "C" void kernel_launch(void* const* d_in, const int* in_sizes, int n_in, void* d_out, int out_size, void* d_ws, size_t ws_size, hipStream_t stream) {
    static int grid = 0;
    if (grid == 0) {
        if (n_in != 14 || in_sizes[0] != M * D || out_size != M * D || ws_size < WS_END) { fprintf(stderr, "kernel_launch: unexpected shapes: n_in %d in0 %d out %d ws %zu (need %zu)\n", n_in, n_in > 0 ? in_sizes[0] : -1, out_size, ws_size, (size_t)WS_END); grid = -1; return; }
        int dev = 0, cus = 0, per_cu = 0;
        if (hipGetDevice(&dev) != hipSuccess || hipDeviceGetAttribute(&cus, hipDeviceAttributeMultiprocessorCount, dev) != hipSuccess) { grid = -1; return; }
        if (hipFuncSetAttribute((const void*)fwd, hipFuncAttributeMaxDynamicSharedMemorySize, LDS_BYTES) != hipSuccess) { fprintf(stderr, "kernel_launch: hipFuncSetAttribute failed\n"); grid = -1; return; }
        if (hipOccupancyMaxActiveBlocksPerMultiprocessor(&per_cu, (const void*)fwd, NWAVES * 64, LDS_BYTES) != hipSuccess || per_cu < 1) fprintf(stderr, "kernel_launch: occupancy query reports %d\n", per_cu);
        (void)hipGetLastError();
        grid = cus;
    }
    if (grid < 0) return;
    if (hipMemsetAsync((char*)d_ws + WS_CTL, 0, CTL_ZERO_BYTES, stream) != hipSuccess) return;
    Args a{};
    for (int i = 0; i < 14; ++i) a.in[i] = (const float*)d_in[i];
    a.out = (float*)d_out; a.ws = (unsigned char*)d_ws;
#if MK_N_LAUNCHES == 1
    a.ph_lo = 0; a.ph_hi = 10;
    hipLaunchKernelGGL(fwd, dim3(grid), dim3(NWAVES * 64), LDS_BYTES, stream, a);
#else
    for (int p = 0; p < 10; ++p) { a.ph_lo = p; a.ph_hi = p + 1; hipLaunchKernelGGL(fwd, dim3(grid), dim3(NWAVES * 64), LDS_BYTES, stream, a); }
#endif
}
```

```cpp
#include <hip/hip_runtime.h>
#include <cstdio>
#include <cstdint>
namespace pg8 {
#define PG8_LAS __attribute__((address_space(3)))
typedef unsigned short bf16_t;
typedef short bf16x8 __attribute__((ext_vector_type(8)));
typedef float f32x4 __attribute__((ext_vector_type(4)));
typedef unsigned u32x4 __attribute__((ext_vector_type(4)));
constexpr int BM = 256, BK = 64, HALF = 128, HTB = HALF * BK * 2  , STAGE_BYTES = 8 * HTB, NXCD = 8, WGM = 8;

__host__ __device__ __forceinline__ int lds_byte(int r, int c) { const int st = (r >> 4) * 2 + (c >> 5), rr = r & 15, cc = c & 31, ob = rr * 64 + cc * 2; return st * 1024 + (ob ^ (((ob >> 9) & 1) << 5)); }
__host__ __device__ __forceinline__ void stage_rc(int b, int& R, int& C) { const int st = b / 1024, sb = b % 1024, swz = sb ^ (((sb >> 9) & 1) << 5); R = (st >> 1) * 16 + swz / 64; C = (st & 1) * 32 + (swz % 64) / 2; }
__host__ __device__ __forceinline__ int perm32(int rho) { const int n = rho >> 4, i = rho & 15; return 8 * (i >> 2) + 4 * n + (i & 3); }

struct Unit { int pm, pn; };
struct Gemm { const bf16_t* A; const bf16_t* Bt; int M, N, K; int sw = 0x7F7F7F7F, sa = 0x7F7F7F7F; };

struct StaticOrder {
    int nM, nN, nwg, G, c;
    __host__ __device__ void init(int M, int N, int G_, int c_) { nM = M / BM; nN = N / BM; nwg = nM * nN; G = G_; c = c_; }
    __host__ __device__ bool next(int i, Unit& u) const {
        const long L = (long)i * G + c; if (L >= nwg) return false;
        int wgid = (int)L; { const int q = nwg / NXCD, r = nwg % NXCD, xcd = wgid % NXCD, off = wgid / NXCD; wgid = (xcd < r ? xcd * (q + 1) : r * (q + 1) + (xcd - r) * q) + off; }
        const int nig = WGM * nN, gid = wgid / nig, fm = gid * WGM, gsz = (nM - fm) < WGM ? (nM - fm) : WGM;
        u.pm = fm + ((wgid % nig) % gsz); u.pn = (wgid % nig) / gsz; return true;
    }
    __device__ __forceinline__ void a_ready(const Unit&) const {}
    __device__ __forceinline__ void done(const Unit&) const {}
};

__device__ __forceinline__ unsigned cvt_pk_bf16(float lo, float hi) { unsigned r; asm volatile("v_cvt_pk_bf16_f32 %0, %1, %2" : "=v"(r) : "v"(lo), "v"(hi)); return r; }
typedef float f32x2 __attribute__((ext_vector_type(2)));
__device__ __forceinline__ f32x2 gelu_pk(f32x2 v) {
    const f32x2 av = __builtin_elementwise_abs(v), d = av * 0.2316418882f + 1.0f;
    f32x2 t; t.x = __builtin_amdgcn_rcpf(d.x); t.y = __builtin_amdgcn_rcpf(d.y);
    f32x2 q = t * 0.5307027145f + (-0.7265760135f); q = q * t + 0.7107068705f; q = q * t + (-0.142248368f); q = q * t + 0.127414796f; q = q * t;
    const f32x2 s = (v * v) * (-0.72134752044f);
    f32x2 e; e.x = __builtin_amdgcn_exp2f(s.x); e.y = __builtin_amdgcn_exp2f(s.y);
    const f32x2 m = v * (q * e), r = v - m;
    f32x2 o; o.x = v.x < 0.f ? m.x : r.x; o.y = v.y < 0.f ? m.y : r.y; return o;
}

template <int ACT  > struct EpiBf16 {
    static constexpr bool PERM = true, AFTER_DRAIN = false; static_assert(ACT == 0 || ACT == 1, "EpiBf16: ACT is 0 (none) or 1 (gelu_pk)");
    bf16_t* O; int ldc; const float* bias; int split_cols; size_t split_stride; float scale0;
    __device__ __forceinline__ void operator()(const f32x4 (&acc)[2][2][4][2], const Unit& u, int wr, int wc, int fr, int fq) const {
        const int row0 = u.pm * BM + wr * 64 + fr; int colt = u.pn * BM; bf16_t* base = O;
        float sc = 1.f; if (split_cols) { const int t = colt / split_cols; base += (size_t)t * split_stride; colt -= t * split_cols; if (t == 0) sc = scale0; }
        const int col0 = colt + wc * 32 + 8 * fq, bcol0 = u.pn * BM + wc * 32 + 8 * fq;
        f32x4 bv[2][2];
#pragma unroll
        for (int bj = 0; bj < 2; ++bj)
#pragma unroll
            for (int n = 0; n < 2; ++n) bv[bj][n] = bias ? *(const f32x4*)(bias + bcol0 + bj * HALF + 4 * n) : (f32x4){0.f, 0.f, 0.f, 0.f};
#pragma unroll
        for (int ai = 0; ai < 2; ++ai)
#pragma unroll
            for (int m = 0; m < 4; ++m) { bf16_t* rowp = base + (size_t)(row0 + ai * HALF + m * 16) * ldc + col0;
#pragma unroll
                for (int bj = 0; bj < 2; ++bj) { f32x4 v0 = acc[ai][bj][m][0] + bv[bj][0], v1 = acc[ai][bj][m][1] + bv[bj][1];
                    if (ACT == 1) { f32x2 a = gelu_pk((f32x2){v0[0], v0[1]}), b = gelu_pk((f32x2){v0[2], v0[3]}), c = gelu_pk((f32x2){v1[0], v1[1]}), d = gelu_pk((f32x2){v1[2], v1[3]});
                        v0 = (f32x4){a.x, a.y, b.x, b.y}; v1 = (f32x4){c.x, c.y, d.x, d.y}; }
                    v0 = v0 * sc; v1 = v1 * sc; u32x4 w; w.x = cvt_pk_bf16(v0[0], v0[1]); w.y = cvt_pk_bf16(v0[2], v0[3]); w.z = cvt_pk_bf16(v1[0], v1[1]); w.w = cvt_pk_bf16(v1[2], v1[3]);
                    *(u32x4*)(rowp + bj * HALF) = w; } }
    }
};
struct EpiGateRes {
    static constexpr bool PERM = false, AFTER_DRAIN = false;
    const float* base; float* out; int ldc; const float* gate; int gate_stride;
    __device__ __forceinline__ void operator()(const f32x4 (&acc)[2][2][4][2], const Unit& u, int wr, int wc, int fr, int fq) const {
        const int row0 = u.pm * BM + wr * 64 + fr, col0 = u.pn * BM + wc * 32 + 4 * fq;
        const float* g = gate + (size_t)((u.pm * BM) >> 12) * gate_stride + col0;
        f32x4 gv[2][2];
#pragma unroll
        for (int bj = 0; bj < 2; ++bj)
#pragma unroll
            for (int n = 0; n < 2; ++n) gv[bj][n] = *(const f32x4*)(g + bj * HALF + n * 16);
#pragma unroll
        for (int ai = 0; ai < 2; ++ai)
#pragma unroll
            for (int m = 0; m < 4; ++m) { const size_t off = (size_t)(row0 + ai * HALF + m * 16) * ldc + col0;
#pragma unroll
                for (int bj = 0; bj < 2; ++bj)
#pragma unroll
                    for (int n = 0; n < 2; ++n) { const f32x4 bs = *(const f32x4*)(base + off + bj * HALF + n * 16); const f32x4 o = bs + gv[bj][n] * acc[ai][bj][m][n]; *(f32x4*)(out + off + bj * HALF + n * 16) = o; }
                if (m & 1) asm volatile("" ::: "memory"); }
    }
};
struct EpiSwiGLU {
    static constexpr bool PERM = true, AFTER_DRAIN = false;
    bf16_t* O; int ldc;
    __device__ __forceinline__ static float silu_mul(float g, float u) { return g * __builtin_amdgcn_rcpf(1.0f + __builtin_amdgcn_exp2f(g * -1.4426950408889634f)) * u; }
    __device__ __forceinline__ void operator()(const f32x4 (&acc)[2][2][4][2], const Unit& u, int wr, int wc, int fr, int fq) const {
        const int row0 = u.pm * BM + wr * 64 + fr, col0 = u.pn * HALF + wc * 32 + 8 * fq;
#pragma unroll
        for (int ai = 0; ai < 2; ++ai)
#pragma unroll
            for (int m = 0; m < 4; ++m) { bf16_t* rowp = O + (size_t)(row0 + ai * HALF + m * 16) * ldc + col0;
                const f32x4 g0 = acc[ai][0][m][0], g1 = acc[ai][0][m][1], u0 = acc[ai][1][m][0], u1 = acc[ai][1][m][1];
                u32x4 w; w.x = cvt_pk_bf16(silu_mul(g0[0], u0[0]), silu_mul(g0[1], u0[1])); w.y = cvt_pk_bf16(silu_mul(g0[2], u0[2]), silu_mul(g0[3], u0[3]));
                w.z = cvt_pk_bf16(silu_mul(g1[0], u1[0]), silu_mul(g1[1], u1[1])); w.w = cvt_pk_bf16(silu_mul(g1[2], u1[2]), silu_mul(g1[3], u1[3]));
                *(u32x4*)rowp = w; }
    }
};
struct EpiSwiGLU8 {
    static constexpr bool PERM = true, AFTER_DRAIN = false;
    unsigned char* O; int ldc; float oscale;
    __device__ __forceinline__ void operator()(const f32x4 (&acc)[2][2][4][2], const Unit& u, int wr, int wc, int fr, int fq) const {
        const int row0 = u.pm * BM + wr * 64 + fr, col0 = u.pn * HALF + wc * 32 + 8 * fq;
#pragma unroll
        for (int ai = 0; ai < 2; ++ai)
#pragma unroll
            for (int m = 0; m < 4; ++m) { unsigned char* rowp = O + (size_t)(row0 + ai * HALF + m * 16) * ldc + col0;
                const f32x4 g0 = acc[ai][0][m][0], g1 = acc[ai][0][m][1], u0 = acc[ai][1][m][0], u1 = acc[ai][1][m][1];
                int w0 = __builtin_amdgcn_cvt_pk_fp8_f32(EpiSwiGLU::silu_mul(g0[0], u0[0]) * oscale, EpiSwiGLU::silu_mul(g0[1], u0[1]) * oscale, 0, false);
                w0 = __builtin_amdgcn_cvt_pk_fp8_f32(EpiSwiGLU::silu_mul(g0[2], u0[2]) * oscale, EpiSwiGLU::silu_mul(g0[3], u0[3]) * oscale, w0, true);
                int w1 = __builtin_amdgcn_cvt_pk_fp8_f32(EpiSwiGLU::silu_mul(g1[0], u1[0]) * oscale, EpiSwiGLU::silu_mul(g1[1], u1[1]) * oscale, 0, false);
                w1 = __builtin_amdgcn_cvt_pk_fp8_f32(EpiSwiGLU::silu_mul(g1[2], u1[2]) * oscale, EpiSwiGLU::silu_mul(g1[3], u1[3]) * oscale, w1, true);
                typedef int i32x2_ __attribute__((ext_vector_type(2)));
                *(i32x2_*)rowp = (i32x2_){w0, w1}; }
    }
};
struct EpiProj {
    static constexpr bool PERM = true, AFTER_DRAIN = false;
    bf16_t* QKVA; bf16_t* P2; int ldp;
    __device__ __forceinline__ void operator()(const f32x4 (&acc)[2][2][4][2], const Unit& u, int wr, int wc, int fr, int fq) const {
        const int row0 = u.pm * BM + wr * 64 + fr;
#pragma unroll
        for (int ai = 0; ai < 2; ++ai)
#pragma unroll
            for (int m = 0; m < 4; ++m) { const int row = row0 + ai * HALF + m * 16;
#pragma unroll
                for (int bj = 0; bj < 2; ++bj) { const f32x4 v0 = acc[ai][bj][m][0], v1 = acc[ai][bj][m][1];
                    u32x4 w; w.x = cvt_pk_bf16(v0[0], v0[1]); w.y = cvt_pk_bf16(v0[2], v0[3]); w.z = cvt_pk_bf16(v1[0], v1[1]); w.w = cvt_pk_bf16(v1[2], v1[3]);
                    const int col = u.pn * BM + bj * HALF + wc * 32 + 8 * fq;
                    bf16_t* dst;
                    if (u.pn < 6) dst = QKVA + (size_t)(col >> 9) * ((size_t)32768 * 512) + ((size_t)((row >> 12) * 8 + ((col & 511) >> 6)) * 4096 + (row & 4095)) * 64 + (col & 63);
                    else dst = P2 + (size_t)row * ldp + (col - 1536);
                    *(u32x4*)dst = w; } }
    }
};
template <class Epi, class Sched, bool ALIGN_EPI = false, bool SP2 = false, bool FP8 = false>
__device__ __forceinline__ void gemm_phase(PG8_LAS unsigned char* lds, const Gemm g, const Sched& S, const Epi& E) {
    int tid_ = threadIdx.x; asm volatile("" : "+v"(tid_));
    const int tid = tid_, wid = __builtin_amdgcn_readfirstlane(tid >> 6), lane = tid & 63, wr = wid >> 2, wc = wid & 3, fr = lane & 15, fq = lane >> 4;
    const int K = g.K, nt = K / BK;
    unsigned voffA[2], voffB[2];
#pragma unroll
    for (int i = 0; i < 2; ++i) { int R, C; stage_rc(tid * 16 + i * 8192, R, C); const int Rb = Epi::PERM ? ((R & ~31) + perm32(R & 31)) : R;
        voffA[i] = (unsigned)(R * K + C) * 2u; voffB[i] = (unsigned)(Rb * K + C) * 2u; }
    const size_t kstep = (size_t)(BK * 2);
    const size_t hstep = (size_t)HALF * K * 2;
    const size_t tstep = 2 * hstep;
    const unsigned ldsw = (unsigned)wid * 1024u;
    const int aoff = lds_byte(wr * 64 + fr, fq * 8), boff = lds_byte(wc * 32 + fr, fq * 8);
#define PG8_SA(b, h) (((b) * 2 + (h)) * HTB)
#define PG8_SB(b, h) ((4 + (b) * 2 + (h)) * HTB)
#define PG8_STAGE(bufoff, gbase, voff) do { _Pragma("unroll") for (int _i = 0; _i < 2; ++_i) \
        __builtin_amdgcn_global_load_lds((const unsigned*)((const char*)(gbase) + (voff)[_i]), (PG8_LAS unsigned*)(lds + (bufoff) + ldsw + _i * 8192), 16, 0, 0); } while (0)
#define PG8_LDA(dst, b, h) do { _Pragma("unroll") for (int m = 0; m < 4; ++m) { if constexpr (FP8) { const v4i_ lo_ = *(const PG8_LAS v4i_*)(lds + PG8_SA(b, h) + aoff + m * 2048), hi_ = *(const PG8_LAS v4i_*)(lds + PG8_SA(b, h) + aoff + m * 2048 + 1024); \
        dst##8[m] = __builtin_shufflevector(lo_, hi_, 0, 1, 2, 3, 4, 5, 6, 7); } else { _Pragma("unroll") for (int k = 0; k < 2; ++k) dst[m][k] = *(const PG8_LAS bf16x8*)(lds + PG8_SA(b, h) + aoff + m * 2048 + k * 1024); } } } while (0)
#define PG8_LDB(dst, b, h) do { _Pragma("unroll") for (int n = 0; n < 2; ++n) { if constexpr (FP8) { const v4i_ lo_ = *(const PG8_LAS v4i_*)(lds + PG8_SB(b, h) + boff + n * 2048), hi_ = *(const PG8_LAS v4i_*)(lds + PG8_SB(b, h) + boff + n * 2048 + 1024); \
        dst##8[n] = __builtin_shufflevector(lo_, hi_, 0, 1, 2, 3, 4, 5, 6, 7); } else { _Pragma("unroll") for (int k = 0; k < 2; ++k) dst[n][k] = *(const PG8_LAS bf16x8*)(lds + PG8_SB(b, h) + boff + n * 2048 + k * 1024); } } } while (0)
#define PG8_MMA(ai, bj, At, Bt) do { __builtin_amdgcn_s_setprio(1); _Pragma("unroll") for (int m = 0; m < 4; ++m) _Pragma("unroll") for (int n = 0; n < 2; ++n) { \
        if constexpr (FP8) asm volatile("v_mfma_scale_f32_16x16x128_f8f6f4 %0, %1, %2, %0, %3, %4 op_sel_hi:[0,0,0]" : "+v"(acc[ai][bj][m][n]) : "v"(Bt##8[n]), "v"(At##8[m]), "v"(sw_), "v"(sa_));   \
        else { _Pragma("unroll") for (int k = 0; k < 2; ++k) acc[ai][bj][m][n] = __builtin_amdgcn_mfma_f32_16x16x32_bf16(Bt[n][k], At[m][k], acc[ai][bj][m][n], 0, 0, 0); } } \
        __builtin_amdgcn_s_setprio(0); } while (0)
#define PG8_WAIT_V(n) asm volatile("s_waitcnt vmcnt(" #n ")" ::: "memory")
#define PG8_WAIT_L(n) asm volatile("s_waitcnt lgkmcnt(" #n ")" ::: "memory")
#define PG8_BAR __builtin_amdgcn_s_barrier()
#define PG8_SCHED __builtin_amdgcn_sched_barrier(0)
    Unit cur, nxt; int ui = 0;
    if (!S.next(0, cur)) return;
    f32x4 acc[2][2][4][2];
#pragma unroll
    for (int a = 0; a < 2; ++a)
#pragma unroll
        for (int b = 0; b < 2; ++b)
#pragma unroll
            for (int m = 0; m < 4; ++m)
#pragma unroll
                for (int n = 0; n < 2; ++n) acc[a][b][m][n] = (f32x4){0.f, 0.f, 0.f, 0.f};
    typedef int v4i_ __attribute__((ext_vector_type(4))); typedef int v8i_ __attribute__((ext_vector_type(8)));
    bf16x8 At[4][2], B0[2][2], B1[2][2]; v8i_ At8[4], B08[2], B18[2];
    const int sw_ = g.sw, sa_ = g.sa;
    const char* cA = (const char*)g.A + (size_t)cur.pm * tstep; const char* cB = (const char*)g.Bt + (size_t)cur.pn * tstep;
    S.a_ready(cur);
    if constexpr (SP2) {
        PG8_STAGE(PG8_SB(0, 0), cB, voffB); PG8_STAGE(PG8_SB(0, 1), cB + hstep, voffB); PG8_STAGE(PG8_SA(0, 0), cA, voffA); PG8_STAGE(PG8_SA(0, 1), cA + hstep, voffA);
        if (wr == 1) PG8_BAR;
        PG8_WAIT_V(2); PG8_BAR;
        PG8_STAGE(PG8_SB(1, 0), cB + kstep, voffB); PG8_STAGE(PG8_SA(1, 0), cA + kstep, voffA); PG8_STAGE(PG8_SB(1, 1), cB + hstep + kstep, voffB);
        PG8_WAIT_V(6); PG8_BAR;
    } else {
        PG8_STAGE(PG8_SB(0, 0), cB, voffB); PG8_STAGE(PG8_SA(0, 0), cA, voffA); PG8_STAGE(PG8_SB(0, 1), cB + hstep, voffB); PG8_STAGE(PG8_SA(0, 1), cA + hstep, voffA);
        if (wr == 1) PG8_BAR;
        PG8_WAIT_V(4); PG8_BAR;
        PG8_STAGE(PG8_SB(1, 0), cB + kstep, voffB); PG8_STAGE(PG8_SA(1, 0), cA + kstep, voffA); PG8_STAGE(PG8_SB(1, 1), cB + hstep + kstep, voffB);
        PG8_WAIT_V(6); PG8_BAR;
    }
    for (;;) {
        const bool has_next = S.next(ui + 1, nxt);
        const char* nA = has_next ? (const char*)g.A + (size_t)nxt.pm * tstep : cA; const char* nB = has_next ? (const char*)g.Bt + (size_t)nxt.pn * tstep : cB;
        for (int t = 0; t < nt; t += 2) {
            const bool last = (t == nt - 2);
            const char* a1 = cA + (size_t)(t + 1) * kstep;
            const char* a2 = last ? nA : cA + (size_t)(t + 2) * kstep; const char* b2 = last ? nB : cB + (size_t)(t + 2) * kstep;
            const char* a3 = a2 + kstep; const char* b3 = b2 + kstep;
            if (last && has_next) S.a_ready(nxt);
            if constexpr (SP2) {
            PG8_LDB(B0, 0, 0); PG8_LDB(B1, 0, 1); PG8_SCHED; PG8_LDA(At, 0, 0); PG8_STAGE(PG8_SA(1, 1), a1 + hstep, voffA);
            PG8_WAIT_V(8); PG8_WAIT_L(0); PG8_BAR; PG8_MMA(0, 0, At, B0); PG8_MMA(0, 1, At, B1); PG8_BAR; PG8_SCHED;
            PG8_LDA(At, 0, 1); PG8_STAGE(PG8_SB(0, 0), b2, voffB); PG8_STAGE(PG8_SB(0, 1), b2 + hstep, voffB); PG8_STAGE(PG8_SA(0, 0), a2, voffA);
            PG8_WAIT_V(8); PG8_WAIT_L(0); PG8_BAR; PG8_MMA(1, 0, At, B0); PG8_MMA(1, 1, At, B1); PG8_BAR; PG8_SCHED;
            PG8_LDB(B0, 1, 0); PG8_LDB(B1, 1, 1); PG8_SCHED; PG8_LDA(At, 1, 0); PG8_STAGE(PG8_SA(0, 1), a2 + hstep, voffA);
            PG8_WAIT_V(8); PG8_WAIT_L(0); PG8_BAR; PG8_MMA(0, 0, At, B0); PG8_MMA(0, 1, At, B1); PG8_BAR; PG8_SCHED;
            PG8_LDA(At, 1, 1); PG8_STAGE(PG8_SB(1, 0), b3, voffB); PG8_STAGE(PG8_SB(1, 1), b3 + hstep, voffB); PG8_STAGE(PG8_SA(1, 0), a3, voffA);
            PG8_WAIT_V(8); PG8_WAIT_L(0); PG8_BAR; PG8_MMA(1, 0, At, B0); PG8_MMA(1, 1, At, B1); PG8_BAR; PG8_SCHED;
            } else {
            PG8_LDB(B0, 0, 0); PG8_SCHED; PG8_LDA(At, 0, 0); PG8_STAGE(PG8_SA(1, 1), a1 + hstep, voffA);
            PG8_WAIT_L(8); PG8_BAR; PG8_WAIT_L(0); PG8_MMA(0, 0, At, B0); PG8_BAR; PG8_SCHED;
            PG8_LDB(B1, 0, 1); PG8_STAGE(PG8_SB(0, 0), b2, voffB);
            PG8_BAR; PG8_WAIT_L(0); PG8_MMA(0, 1, At, B1); PG8_BAR;
            PG8_LDA(At, 0, 1); PG8_STAGE(PG8_SA(0, 0), a2, voffA);
            PG8_BAR; PG8_WAIT_L(0); PG8_MMA(1, 0, At, B0); PG8_BAR; PG8_SCHED;
            PG8_STAGE(PG8_SB(0, 1), b2 + hstep, voffB);
            PG8_WAIT_V(6); PG8_BAR; PG8_MMA(1, 1, At, B1); PG8_BAR;
            PG8_LDB(B0, 1, 0); PG8_SCHED; PG8_LDA(At, 1, 0); PG8_STAGE(PG8_SA(0, 1), a2 + hstep, voffA);
            PG8_WAIT_L(8); PG8_BAR; PG8_WAIT_L(0); PG8_MMA(0, 0, At, B0); PG8_BAR; PG8_SCHED;
            PG8_LDB(B1, 1, 1); PG8_STAGE(PG8_SB(1, 0), b3, voffB);
            PG8_BAR; PG8_WAIT_L(0); PG8_MMA(0, 1, At, B1); PG8_BAR;
            PG8_LDA(At, 1, 1); PG8_STAGE(PG8_SA(1, 0), a3, voffA);
            PG8_BAR; PG8_WAIT_L(0); PG8_MMA(1, 0, At, B0); PG8_BAR; PG8_SCHED;
            PG8_STAGE(PG8_SB(1, 1), b3 + hstep, voffB);
            PG8_WAIT_V(6); PG8_BAR; PG8_MMA(1, 1, At, B1); PG8_BAR;
            }
        }
        if constexpr (FP8) asm volatile("s_nop 15\n\ts_nop 15" ::: "memory");
        if constexpr (ALIGN_EPI) { if (wr == 0) PG8_BAR; }
        if constexpr (!Epi::AFTER_DRAIN) { E(acc, cur, wr, wc, fr, fq); S.done(cur); }
        if (!has_next) break;
#pragma unroll
        for (int a = 0; a < 2; ++a)
#pragma unroll
            for (int b = 0; b < 2; ++b)
#pragma unroll
                for (int m = 0; m < 4; ++m)
#pragma unroll
                    for (int n = 0; n < 2; ++n) acc[a][b][m][n] = (f32x4){0.f, 0.f, 0.f, 0.f};
        cur = nxt; cA = nA; cB = nB; ++ui;
        if constexpr (ALIGN_EPI) { if (wr == 1) PG8_BAR; }
    }
    PG8_WAIT_V(0);
    if constexpr (!ALIGN_EPI) { if (wr == 0) PG8_BAR; }
    PG8_BAR;
    if constexpr (Epi::AFTER_DRAIN) { E.fused(acc, cur, wr, wc, fr, fq, lds, wid, lane); S.done(cur); }
#undef PG8_SA
#undef PG8_SB
#undef PG8_STAGE
#undef PG8_LDA
#undef PG8_LDB
#undef PG8_MMA
#undef PG8_WAIT_V
#undef PG8_WAIT_L
#undef PG8_BAR
#undef PG8_SCHED
}
}
constexpr int NWAVES = 8;
constexpr int BATCH = 8, T = 4096, D = 1024, M = BATCH * T;
constexpr int DIN = 2760;
constexpr int NPROJ = 3328;
constexpr int W_QL = 1536, W_END = 3272;
constexpr int NP2 = 1792, C_QL = 0, C_CKV = 1024, C_QI = 1152, C_KI = 1664, C_WI = 1728;
constexpr int KOUT = 1536;
constexpr int DFF = 2816, NGU = 2 * DFF;
constexpr int TOPK = 256, RLAT = 128;
constexpr float EPS = 1e-6f;
constexpr float LOG2E = 1.4426950408889634f;
constexpr float IDX_SCALE = 0.044194173824159216f;
#ifndef FFN_FP8
#define FFN_FP8 1
#endif
constexpr float W8_SCALE = 64.f, X8_SCALE = 8.f, H8_SCALE = 16.f;
constexpr int E8_W = 0x7F7F7F7F - 0x06060606, E8_X = 0x7F7F7F7F - 0x03030303, E8_H = 0x7F7F7F7F - 0x04040404;

constexpr size_t MiB = 1u << 20;
constexpr size_t WS_CTL = 0, CTL_ZERO_BYTES = 1 * MiB;
constexpr size_t WS_MOD = 1 * MiB;
constexpr size_t WS_WIN = 2 * MiB;
constexpr size_t WS_WOUT = 9 * MiB;
constexpr size_t WS_WGU = 12 * MiB;
constexpr size_t WS_WDN = 23 * MiB;
constexpr size_t WS_CKVN = 29 * MiB;
constexpr size_t WS_IDX = 37 * MiB;
constexpr size_t WS_XN = 54 * MiB;
constexpr size_t WS_MIX = 118 * MiB;
constexpr size_t WS_PROJ = 214 * MiB;
constexpr size_t WS_H = WS_PROJ;
constexpr size_t WS_QKVA = 326 * MiB;
constexpr size_t WS_END = 422 * MiB;
static_assert(WS_WIN + (size_t)NPROJ * D * 2 <= WS_WOUT && WS_WOUT + (size_t)D * KOUT * 2 <= WS_WGU && WS_WGU + (size_t)NGU * D * 2 <= WS_WDN && WS_WDN + (size_t)D * DFF * 2 <= WS_CKVN, "ws map 1");
static_assert(WS_CKVN + (size_t)M * 128 * 2 <= WS_IDX && WS_IDX + (size_t)M * 256 * 2 <= WS_XN && WS_XN + (size_t)M * D * 2 <= WS_MIX && WS_MIX + (size_t)M * KOUT * 2 <= WS_PROJ && WS_PROJ + (size_t)M * NP2 * 2 <= WS_QKVA && WS_QKVA + (size_t)3 * M * 512 * 2 <= WS_END && WS_H + (size_t)M * DFF <= WS_QKVA, "ws map 2");
constexpr int CW_TMO = 0, CW_CODE = 1, CW_ERR = 2;
constexpr int CW_BAR = 4096;

constexpr int RING_OFF = 0, RING_BYTES = 131072;
constexpr int LDSCTL_OFF = RING_BYTES, MISC_OFF = LDSCTL_OFF + 320;
constexpr int EX_OFF = LDSCTL_OFF + 512, EX_BYTES = 1024 + 8 * 3072;
constexpr int LDS_BYTES = EX_OFF + EX_BYTES;
#define GAS __attribute__((address_space(1)))
#define LAS __attribute__((address_space(3)))
typedef unsigned short bf16;
typedef unsigned v4u __attribute__((ext_vector_type(4)));
typedef float f32x4 __attribute__((ext_vector_type(4)));
typedef short bf16x8 __attribute__((ext_vector_type(8)));
typedef GAS unsigned gu32;
typedef GAS unsigned long long gu64;
#define RLX_AGENT __ATOMIC_RELAXED, __HIP_MEMORY_SCOPE_AGENT
#define LDS_WAIT() asm volatile("s_waitcnt lgkmcnt(0)" ::: "memory")
#define VM_WAIT() asm volatile("s_waitcnt vmcnt(0)" ::: "memory")
__device__ __forceinline__ unsigned long long rt() { return __builtin_amdgcn_s_memrealtime(); }
__device__ __forceinline__ unsigned f2bf(float f) { unsigned u = __builtin_bit_cast(unsigned, f); return (u + 0x7fffu + ((u >> 16) & 1u)) >> 16; }
__device__ __forceinline__ unsigned pk2(float lo, float hi) { return f2bf(lo) | (f2bf(hi) << 16); }
#define XB_TMO      128
#define XB_XCNT(j)  (256  + 64 * (j))
#define XB_XSUB(j)  (1280 + 64 * (j))
#define XB_XGEN(j)  (2304 + 64 * (j))
#define XB_TOP      3328
#define XB_TOPGEN   3392
#define XCD_BAR_WORDS 3456
#define XB_SPIN_CAP (1u << 18)

__device__ __forceinline__ unsigned xb_ld(unsigned* p)              { return __hip_atomic_load(p, __ATOMIC_RELAXED, __HIP_MEMORY_SCOPE_AGENT); }
__device__ __forceinline__ unsigned xb_add(unsigned* p, unsigned v) { return __hip_atomic_fetch_add(p, v, __ATOMIC_RELAXED, __HIP_MEMORY_SCOPE_AGENT); }
__device__ __forceinline__ unsigned xb_xcc_id() { return (unsigned)__builtin_amdgcn_s_getreg((3 << 11) | 20) & 0xFu; }
#define XB_SPIN(cond, bar) do { unsigned _sp = 0; while (cond) { __builtin_amdgcn_s_sleep(1); \
    if ((++_sp & 255u) == 0u) { if (xb_ld(&(bar)[XB_TMO])) break; if (_sp > XB_SPIN_CAP) { atomicAdd(&(bar)[XB_TMO], 1u); break; } } } } while (0)

struct XcdBarrier {
    unsigned* bar; unsigned x;
    volatile LAS unsigned* st;
};

__device__ __forceinline__ XcdBarrier xcd_barrier_post(unsigned* bar, volatile LAS unsigned* st) {
    XcdBarrier b; b.bar = bar; b.x = xb_xcc_id(); b.st = st;
    if (threadIdx.x == 0) (void)xb_add(&bar[XB_XCNT(b.x)], 1u);
    return b;
}
__device__ __forceinline__ void xcd_barrier_complete(unsigned* bar, unsigned x, unsigned& nloc, unsigned& nx) {
    const unsigned G = gridDim.x * gridDim.y * gridDim.z;
    unsigned sum, cnt, mine, sp = 0u;
    for (;;) {
        sum = 0u; cnt = 0u; mine = 0u;
#pragma unroll
        for (unsigned j = 0; j < 16; ++j) { const unsigned c = xb_ld(&bar[XB_XCNT(j)]); sum += c; cnt += (c > 0u) ? 1u : 0u; mine = (j == x) ? c : mine; }
        if (sum == G) break;
        __builtin_amdgcn_s_sleep(1);
        if ((++sp & 255u) == 0u) { if (xb_ld(&bar[XB_TMO])) break; if (sp > XB_SPIN_CAP) { atomicAdd(&bar[XB_TMO], 1u); break; } }
    }
    nloc = mine > 0u ? mine : 1u; nx = cnt > 0u ? cnt : 1u;
}

__device__ __forceinline__ void xcd_barrier(const XcdBarrier& b) {
    asm volatile("s_waitcnt vmcnt(0)" ::: "memory");
    __syncthreads();
    if (threadIdx.x == 0) {
        unsigned* bar = b.bar;
        __builtin_amdgcn_s_waitcnt(0);
        unsigned nloc = b.st[0], nx = b.st[1];
        if (nloc == 0u) { xcd_barrier_complete(bar, b.x, nloc, nx); b.st[0] = nloc; b.st[1] = nx; }
        const unsigned old = xb_add(&bar[XB_XSUB(b.x)], 1u);
        const unsigned gen = old / nloc;
        if (old + 1u == (gen + 1u) * nloc) {
            __builtin_amdgcn_fence(__ATOMIC_RELEASE, "agent");
            asm volatile("s_waitcnt vmcnt(0)" ::: "memory");
            const unsigned og = xb_add(&bar[XB_TOP], 1u);
            const unsigned tg = og / nx;
            if (og + 1u == (tg + 1u) * nx) xb_add(&bar[XB_TOPGEN], 1u);
            else XB_SPIN(xb_ld(&bar[XB_TOPGEN]) == tg, bar);
            __builtin_amdgcn_fence(__ATOMIC_ACQUIRE, "agent");
            xb_add(&bar[XB_XGEN(b.x)], 1u);
            asm volatile("s_waitcnt vmcnt(0)" ::: "memory");
        } else {
            XB_SPIN(xb_ld(&bar[XB_XGEN(b.x)]) == gen, bar);
            __builtin_amdgcn_fence(__ATOMIC_ACQUIRE, "agent");
            asm volatile("s_waitcnt vmcnt(0)" ::: "memory");
        }
    }
    __syncthreads();
}
typedef float f32x16 __attribute__((ext_vector_type(16)));
typedef short s16x4 __attribute__((ext_vector_type(4)));
typedef unsigned u32x2 __attribute__((ext_vector_type(2)));
typedef float f32x2_t __attribute__((ext_vector_type(2)));
typedef __bf16 bf16x2_t __attribute__((ext_vector_type(2)));
__device__ __forceinline__ unsigned pkbf(float lo, float hi) { f32x2_t v = {lo, hi}; bf16x2_t b = __builtin_convertvector(v, bf16x2_t); return __builtin_bit_cast(unsigned, b); }
__device__ __forceinline__ float bf2f(unsigned short h) { return __builtin_bit_cast(float, (unsigned)h << 16); }
__device__ __forceinline__ float bflo(unsigned w) { return __builtin_bit_cast(float, w << 16); }
__device__ __forceinline__ float bfhi(unsigned w) { return __builtin_bit_cast(float, w & 0xffff0000u); }
__device__ __forceinline__ float ex2(float x) { return __builtin_amdgcn_exp2f(x); }
__device__ __forceinline__ float swap32_max(float v) { auto rr = __builtin_amdgcn_permlane32_swap(__float_as_uint(v), __float_as_uint(v), false, false); return fmaxf(__uint_as_float(rr[0]), __uint_as_float(rr[1])); }
__device__ __forceinline__ float swap32_sum(float v) { auto rr = __builtin_amdgcn_permlane32_swap(__float_as_uint(v), __float_as_uint(v), false, false); return __uint_as_float(rr[0]) + __uint_as_float(rr[1]); }
typedef short v4i16_t __attribute__((ext_vector_type(4)));
__device__ __forceinline__ s16x4 tr16(LAS const unsigned char* p) { return __builtin_bit_cast(s16x4, __builtin_amdgcn_ds_read_tr16_b64_v4i16((LAS v4i16_t*)p)); }

struct Frame {
    LAS unsigned char* lds;
    volatile LAS unsigned* MISC;
    gu32* ctl;
    int tid, lane, wave;
    int G;
    const float *x, *c, *w_ada, *b_ada, *g_attn, *w_in, *kv_g, *w_uk, *w_uv, *w_out, *g_ffn, *w_gu, *w_down, *g_final;
    float* out;
    float* MOD;
    bf16 *WIN, *WOUT, *WGU, *WDN, *CKVN, *XN, *MIX, *PROJ, *HB, *QKVA;
    unsigned short* IDX;
};
__device__ __forceinline__ float wave_sum(float v) {
#pragma unroll
    for (int o = 1; o < 64; o <<= 1) v += __shfl_xor(v, o);
    return v;
}

__device__ __forceinline__ void tr_item(const float* W, int ldw, int k0, int n0, int nvalid, bf16* WT, int ldt, int drow0, LAS float* scr, int lane) {
#pragma unroll 8
    for (int i = 0; i < 32; ++i) { const int kk = 2 * i + (lane >> 5), nn = lane & 31; scr[kk * 33 + nn] = nn < nvalid ? W[(size_t)(k0 + kk) * ldw + n0 + nn] : 0.f; }
    LDS_WAIT(); asm volatile("" ::: "memory");
    const int c = lane & 7;
#pragma unroll
    for (int j = 0; j < 4; ++j) { const int n = (lane >> 3) + 8 * j; const LAS float* s = scr + (8 * c) * 33 + n;
        v4u o; o.x = pk2(s[0 * 33], s[1 * 33]); o.y = pk2(s[2 * 33], s[3 * 33]); o.z = pk2(s[4 * 33], s[5 * 33]); o.w = pk2(s[6 * 33], s[7 * 33]);
        if (n < nvalid) *(GAS v4u*)(WT + (size_t)(drow0 + n) * ldt + k0 + 8 * c) = o; }
    LDS_WAIT(); asm volatile("" ::: "memory");
}
__device__ __forceinline__ void tr_item8(const float* W, int ldw, int k0, int n0, unsigned char* WT, int ldt, int drow0, float wscale, LAS float* scr, int lane) {
#pragma unroll 8
    for (int i = 0; i < 32; ++i) { const int kk = 2 * i + (lane >> 5), nn = lane & 31; scr[kk * 33 + nn] = W[(size_t)(k0 + kk) * ldw + n0 + nn]; }
    LDS_WAIT(); asm volatile("" ::: "memory");
    const int c = lane & 3;
#pragma unroll
    for (int j = 0; j < 2; ++j) { const int n = (lane >> 2) + 16 * j; const LAS float* s = scr + (16 * c) * 33 + n;
        int w[4];
#pragma unroll
        for (int q = 0; q < 4; ++q) { int t = __builtin_amdgcn_cvt_pk_fp8_f32(s[(4 * q) * 33] * wscale, s[(4 * q + 1) * 33] * wscale, 0, false); w[q] = __builtin_amdgcn_cvt_pk_fp8_f32(s[(4 * q + 2) * 33] * wscale, s[(4 * q + 3) * 33] * wscale, t, true); }
        *(GAS v4u*)(WT + (size_t)(drow0 + n) * ldt + k0 + 16 * c) = (v4u){(unsigned)w[0], (unsigned)w[1], (unsigned)w[2], (unsigned)w[3]}; }
    LDS_WAIT(); asm volatile("" ::: "memory");
}
__device__ __forceinline__ void p0_prologue(Frame& F) {
    LAS float* L = (LAS float*)(F.lds + RING_OFF);
    const int tid = F.tid, lane = F.lane, wave = F.wave;
    for (int it = blockIdx.x; it < 448; it += F.G) {
        if (it < 192) {
            LAS float* sc = L;
            LAS float* red = L + 8192;
            for (int e = tid; e < 8192; e += 512) { const float v = F.c[e]; sc[e] = v / (1.0f + __expf(-v)); }
            __syncthreads();
            const int j0 = 32 * it, col = lane & 31, ksub = lane >> 5;
            float acc[8];
#pragma unroll
            for (int b = 0; b < 8; ++b) acc[b] = 0.f;
            for (int i = 0; i < 64; ++i) { const int k = 128 * wave + 2 * i + ksub; const float wv = F.w_ada[(size_t)k * 6144 + j0 + col];
#pragma unroll
                for (int b = 0; b < 8; ++b) acc[b] += sc[b * 1024 + k] * wv; }
#pragma unroll
            for (int b = 0; b < 8; ++b) red[((wave * 2 + ksub) * 8 + b) * 32 + col] = acc[b];
            __syncthreads();
            if (tid < 256) { const int b = tid >> 5, cc = tid & 31; float s = F.b_ada[j0 + cc];
#pragma unroll
                for (int p = 0; p < 16; ++p) s += red[(p * 8 + b) * 32 + cc];
                F.MOD[b * 6144 + j0 + cc] = s; }
            __syncthreads();
        } else if (it < 320) {
            const int f = it - 192, h = f >> 4, k0 = 64 * (f & 15);
            LAS float* win_s = L;
            LAS float* wuk_s = L + 64 * 65;
            for (int e = tid; e < 4096; e += 512) { const int kk = e >> 6, d = e & 63; win_s[kk * 65 + d] = F.w_in[(size_t)(k0 + kk) * DIN + 1536 + h * 64 + d]; }
            for (int e = tid; e < 8192; e += 512) wuk_s[e] = F.w_uk[(size_t)h * 8192 + e];
            __syncthreads();
            const int kk = tid & 63, r0 = 16 * (tid >> 6);
            float acc[16];
#pragma unroll
            for (int i = 0; i < 16; ++i) acc[i] = 0.f;
            for (int d = 0; d < 64; ++d) { const float a = win_s[kk * 65 + d];
#pragma unroll
                for (int i = 0; i < 16; ++i) acc[i] += a * wuk_s[d * 128 + r0 + i]; }
#pragma unroll
            for (int i = 0; i < 16; ++i) F.WIN[(size_t)(W_QL + h * 128 + r0 + i) * D + k0 + kk] = (bf16)f2bf(acc[i]);
            __syncthreads();
        } else {
            const int f = it - 320, h = f >> 4, n0 = 64 * (f & 15);
            LAS float* wuv_s = L;
            LAS float* wo_s = L + 128 * 65;
            for (int e = tid; e < 8192; e += 512) { const int r = e >> 6, d = e & 63; wuv_s[r * 65 + d] = F.w_uv[(size_t)h * 8192 + e]; }
            for (int e = tid; e < 4096; e += 512) { const int d = e >> 6, nn = e & 63; wo_s[e] = F.w_out[(size_t)(512 + h * 64 + d) * D + n0 + nn]; }
            __syncthreads();
            const int r = tid & 127, nn0 = 16 * (tid >> 7);
            float acc[16];
#pragma unroll
            for (int i = 0; i < 16; ++i) acc[i] = 0.f;
            for (int d = 0; d < 64; ++d) { const float a = wuv_s[r * 65 + d];
#pragma unroll
                for (int i = 0; i < 16; ++i) acc[i] += a * wo_s[d * 64 + nn0 + i]; }
#pragma unroll
            for (int i = 0; i < 16; ++i) F.WOUT[(size_t)(n0 + nn0 + i) * KOUT + 512 + h * 128 + r] = (bf16)f2bf(acc[i]);
            __syncthreads();
        }
    }
    __syncthreads();
    LAS float* scr = (LAS float*)(F.lds + RING_OFF + wave * 16384);
    const int gw = blockIdx.x * NWAVES + wave, NGW = F.G * NWAVES;
    constexpr int J1 = 16 * 48, J2 = 16 * 23, J4 = 8 * 32, J5 = 16 * 176, J6 = 44 * 32;
    for (int it = gw; it < J1 + J2 + J4 + J5 + J6; it += NGW) {
        int r = it;
        if (r < J1) { const int kb = r / 48, nb = r % 48; tr_item(F.w_in, DIN, 64 * kb, 32 * nb, 32, F.WIN, D, 32 * nb, scr, lane); continue; } r -= J1;
        if (r < J2) { const int kb = r / 23, nb = r % 23; const int n0 = 2048 + 32 * nb; const int nv = (DIN - n0) < 32 ? (DIN - n0) : 32; tr_item(F.w_in, DIN, 64 * kb, n0, nv, F.WIN, D, n0 + 512, scr, lane); continue; } r -= J2;
        if (r < J4) { const int kb = r / 32, nb = r % 32; tr_item(F.w_out, D, 64 * kb, 32 * nb, 32, F.WOUT, KOUT, 32 * nb, scr, lane); continue; } r -= J4;
        if (r < J5) { const int kb = r / 176, nb = r % 176; const int n0 = 32 * nb; const int isup = n0 >= DFF ? 1 : 0; const int u0 = n0 - isup * DFF; const int drow = (u0 >> 7) * 256 + isup * 128 + (u0 & 127);
            if (FFN_FP8) tr_item8(F.w_gu, NGU, 64 * kb, n0, (unsigned char*)F.WGU, D, drow, W8_SCALE, scr, lane); else tr_item(F.w_gu, NGU, 64 * kb, n0, 32, F.WGU, D, drow, scr, lane); continue; } r -= J5;
        { const int kb = r / 32, nb = r % 32; if (FFN_FP8) tr_item8(F.w_down, D, 64 * kb, 32 * nb, (unsigned char*)F.WDN, DFF, 32 * nb, W8_SCALE, scr, lane); else tr_item(F.w_down, D, 64 * kb, 32 * nb, 32, F.WDN, DFF, 32 * nb, scr, lane); }
    }
    { const int gt = blockIdx.x * 512 + tid; const int nchunk = (NPROJ - W_END) * D / 8;
      for (int e = gt; e < nchunk; e += F.G * 512) *(GAS v4u*)(F.WIN + (size_t)W_END * D + (size_t)e * 8) = (v4u){0u, 0u, 0u, 0u}; }
}

__device__ __forceinline__ void modnorm_rows(Frame& F, const float* X, const float* g, int sc_chunk, int sh_chunk, bf16* out) {
    const int gw = blockIdx.x * NWAVES + F.wave, NGW = F.G * NWAVES;
    for (int m = gw; m < M; m += NGW) {
        const int b = m >> 12;
        const GAS f32x4* xr = (const GAS f32x4*)(X + (size_t)m * D) + F.lane;
        const GAS f32x4* gr = (const GAS f32x4*)g + F.lane;
        const GAS f32x4* scr = (const GAS f32x4*)(F.MOD + b * 6144 + sc_chunk * 1024) + F.lane;
        const GAS f32x4* shr = (const GAS f32x4*)(F.MOD + b * 6144 + sh_chunk * 1024) + F.lane;
        f32x4 v[4]; float s = 0.f;
#pragma unroll
        for (int j = 0; j < 4; ++j) { v[j] = xr[64 * j]; s += (v[j].x * v[j].x + v[j].y * v[j].y) + (v[j].z * v[j].z + v[j].w * v[j].w); }
        const float rstd = 1.0f / sqrtf(wave_sum(s) * (1.f / D) + EPS);
        GAS unsigned long long* o8 = (GAS unsigned long long*)(out + (size_t)m * D) + F.lane;
#pragma unroll
        for (int j = 0; j < 4; ++j) { const f32x4 gg = gr[64 * j], sc = scr[64 * j], sh = shr[64 * j];
            const f32x4 y = v[j] * rstd * gg * (sc + 1.0f) + sh;
            o8[64 * j] = (unsigned long long)pkbf(y.x, y.y) | ((unsigned long long)pkbf(y.z, y.w) << 32); }
    }
}
__device__ __forceinline__ void modnorm_rows8(Frame& F, const float* X, const float* g, int sc_chunk, int sh_chunk, unsigned char* out, float oscale) {
    const int gw = blockIdx.x * NWAVES + F.wave, NGW = F.G * NWAVES;
    for (int m = gw; m < M; m += NGW) {
        const int b = m >> 12;
        const GAS f32x4* xr = (const GAS f32x4*)(X + (size_t)m * D) + F.lane;
        const GAS f32x4* gr = (const GAS f32x4*)g + F.lane;
        const GAS f32x4* scr = (const GAS f32x4*)(F.MOD + b * 6144 + sc_chunk * 1024) + F.lane;
        const GAS f32x4* shr = (const GAS f32x4*)(F.MOD + b * 6144 + sh_chunk * 1024) + F.lane;
        f32x4 v[4]; float s = 0.f;
#pragma unroll
        for (int j = 0; j < 4; ++j) { v[j] = xr[64 * j]; s += (v[j].x * v[j].x + v[j].y * v[j].y) + (v[j].z * v[j].z + v[j].w * v[j].w); }
        const float rstd = 1.0f / sqrtf(wave_sum(s) * (1.f / D) + EPS);
        GAS int* o4 = (GAS int*)(out + (size_t)m * D) + F.lane;
#pragma unroll
        for (int j = 0; j < 4; ++j) { const f32x4 gg = gr[64 * j], sc = scr[64 * j], sh = shr[64 * j];
            const f32x4 y = (v[j] * rstd * gg * (sc + 1.0f) + sh) * oscale;
            int w = __builtin_amdgcn_cvt_pk_fp8_f32(y.x, y.y, 0, false); w = __builtin_amdgcn_cvt_pk_fp8_f32(y.z, y.w, w, true);
            o4[64 * j] = w; }
    }
}
__device__ __forceinline__ void final_norm_rows(Frame& F) {
    const int gw = blockIdx.x * NWAVES + F.wave, NGW = F.G * NWAVES;
    for (int m = gw; m < M; m += NGW) {
        GAS f32x4* xr = (GAS f32x4*)(F.out + (size_t)m * D) + F.lane;
        const GAS f32x4* gr = (const GAS f32x4*)F.g_final + F.lane;
        f32x4 v[4]; float s = 0.f;
#pragma unroll
        for (int j = 0; j < 4; ++j) { v[j] = xr[64 * j]; s += (v[j].x * v[j].x + v[j].y * v[j].y) + (v[j].z * v[j].z + v[j].w * v[j].w); }
        const float rstd = 1.0f / sqrtf(wave_sum(s) * (1.f / D) + EPS);
#pragma unroll
        for (int j = 0; j < 4; ++j) xr[64 * j] = v[j] * rstd * gr[64 * j];
    }
}
__device__ __forceinline__ void ckv_norm_rows(Frame& F) {
    const int gw = blockIdx.x * NWAVES + F.wave, NGW = F.G * NWAVES;
    const int sub = F.lane >> 4, c8 = (F.lane & 15) * 8;
    f32x4 g0 = *(const GAS f32x4*)(F.kv_g + c8), g1 = *(const GAS f32x4*)(F.kv_g + c8 + 4);
    for (int it = gw; it < M / 4; it += NGW) {
        const int m = 4 * it + sub;
        const v4u w = *(const GAS v4u*)(F.PROJ + (size_t)m * NP2 + C_CKV + c8);
        float v[8] = {bflo(w.x), bfhi(w.x), bflo(w.y), bfhi(w.y), bflo(w.z), bfhi(w.z), bflo(w.w), bfhi(w.w)};
        float s = 0.f;
#pragma unroll
        for (int j = 0; j < 8; ++j) s += v[j] * v[j];
        s += __shfl_xor(s, 1); s += __shfl_xor(s, 2); s += __shfl_xor(s, 4); s += __shfl_xor(s, 8);
        const float rstd = 1.0f / sqrtf(s * (1.f / 128.f) + EPS);
        v4u o; o.x = pkbf(v[0] * rstd * g0.x, v[1] * rstd * g0.y); o.y = pkbf(v[2] * rstd * g0.z, v[3] * rstd * g0.w);
        o.z = pkbf(v[4] * rstd * g1.x, v[5] * rstd * g1.y); o.w = pkbf(v[6] * rstd * g1.z, v[7] * rstd * g1.w);
        *(GAS v4u*)(F.CKVN + (size_t)m * 128 + c8) = o;
    }
}
namespace ga {
constexpr int OEX_OFF = 0, ML_OFF = 65536, VT_OFF = 69632, VT_BYTES = 4096;
__device__ __forceinline__ unsigned vt_off(unsigned row, unsigned ch) { return 128u * row + 16u * (ch ^ ((((row >> 1) & 1u) << 2) | ((row >> 2) & 3u))); }
__device__ __forceinline__ unsigned ex_f(unsigned row) { return (row ^ (row >> 4)) & 15u; }
template <int STAGE>
__device__ __forceinline__ void run_set(int b, int h, int T0, int sidx, const bf16* QA, const bf16* KA, const bf16* VA, bf16* MIX, LAS unsigned char* lds, LAS unsigned char* vt, int lane) {
    constexpr int d = STAGE == 0 ? 1 : (STAGE == 1 ? 4 : 16);
    const int qi = lane & 31, hi = lane >> 5;
    int roff, P0;
    if (STAGE == 0) { roff = 0; P0 = T0 + 32 * sidx; }
    else if (STAGE == 1) { roff = sidx & 3; P0 = (T0 >> 2) + 32 * (sidx >> 2); }
    else { roff = sidx; P0 = T0 >> 4; }
    const size_t hb = (size_t)(b * 8 + h) * T * 64;
    const int tq = roff + d * (P0 + qi);
    const int row = tq - T0;
    const float slope = exp2f(-0.5f * (float)(2 * h + 1));
    const float sd = slope * LOG2E * (float)d, c2 = 0.125f * LOG2E;
    const int blk = (lane >> 4) & 1, q4 = (lane & 15) >> 2, p4 = lane & 3;
    bf16x8 qf[4];
#pragma unroll
    for (int s = 0; s < 4; ++s) qf[s] = *(const GAS bf16x8*)(QA + hb + (size_t)tq * 64 + 16 * s + 8 * hi);
    float mrun, lsum; f32x16 o0, o1;
    LAS unsigned char* oex = lds + OEX_OFF + row * 128;
    LAS f32x2_t* mlp = (LAS f32x2_t*)(lds + ML_OFF) + ((row & ~15) | (int)ex_f((unsigned)row));
    const unsigned fr = ex_f((unsigned)row);
    if (STAGE == 0) { mrun = -1e30f; lsum = 0.f; o0 = (f32x16){}; o1 = (f32x16){}; }
    else {
        const f32x2_t ml = *mlp; mrun = ml.x; lsum = hi == 0 ? ml.y : 0.f;
#pragma unroll
        for (int mt = 0; mt < 2; ++mt)
#pragma unroll
            for (int gq = 0; gq < 4; ++gq) { const u32x2 w = *(const LAS u32x2*)(oex + (((unsigned)(8 * mt + 2 * gq + hi) ^ fr) << 3));
                f32x16& o = mt == 0 ? o0 : o1; o[4 * gq] = bflo(w.x); o[4 * gq + 1] = bfhi(w.x); o[4 * gq + 2] = bflo(w.y); o[4 * gq + 3] = bfhi(w.y); }
    }
    bf16x8 kn[4], vn[4];
    { int pos = P0 + qi; pos = pos < 0 ? 0 : pos; const size_t ko = hb + (size_t)(roff + d * pos) * 64 + 8 * hi;
#pragma unroll
      for (int s = 0; s < 4; ++s) { kn[s] = *(const GAS bf16x8*)(KA + ko + 16 * s); vn[s] = *(const GAS bf16x8*)(VA + ko + 16 * s); } }
#pragma unroll 1
    for (int a = 4; a >= 0; --a) {
        bf16x8 kf[4], vf[4];
#pragma unroll
        for (int s = 0; s < 4; ++s) { kf[s] = kn[s]; vf[s] = vn[s]; }
        if (a > 0) { int pos = P0 - 128 + 32 * (a - 1) + qi; pos = pos < 0 ? 0 : pos; const size_t ko = hb + (size_t)(roff + d * pos) * 64 + 8 * hi;
#pragma unroll
            for (int s = 0; s < 4; ++s) { kn[s] = *(const GAS bf16x8*)(KA + ko + 16 * s); vn[s] = *(const GAS bf16x8*)(VA + ko + 16 * s); } }
        const int pi0 = P0 - 128 + 32 * a;
        if (pi0 + 31 < 0) continue;
#pragma unroll
        for (int s = 0; s < 4; ++s) *(LAS bf16x8*)(vt + vt_off((unsigned)qi, (unsigned)(2 * s + hi))) = vf[s];
        f32x16 sacc = {};
#pragma unroll
        for (int s = 0; s < 4; ++s) sacc = __builtin_amdgcn_mfma_f32_32x32x16_bf16(kf[s], qf[s], sacc, 0, 0, 0);
        const int jl = qi + 128 - 32 * a - 4 * hi;
        const float bl = -sd * (float)jl;
        float sv[16]; float mx = -1e30f;
        if (a == 0 || a == 4 || pi0 < 0) {
            const int mmin = pi0 < 0 ? -pi0 : 0;
#pragma unroll
            for (int reg = 0; reg < 16; ++reg) { const int mo = (reg & 3) + 8 * (reg >> 2); const int j = jl - mo; const bool ok = (j >= 0) && (j <= 128) && (mo + 4 * hi >= mmin);
                const float v = ok ? fmaf(sacc[reg], c2, fmaf(sd, (float)mo, bl)) : -1e30f; sv[reg] = v; mx = fmaxf(mx, v); }
        } else {
#pragma unroll
            for (int reg = 0; reg < 16; ++reg) { const int mo = (reg & 3) + 8 * (reg >> 2); const float v = fmaf(sacc[reg], c2, fmaf(sd, (float)mo, bl)); sv[reg] = v; mx = fmaxf(mx, v); }
        }
        mx = swap32_max(mx);
        if (__any(mx > mrun)) {
            const float mnew = fmaxf(mrun, mx); const float alpha = ex2(mrun - mnew); mrun = mnew;
            lsum *= alpha; o0 *= alpha; o1 *= alpha;
        }
        float ps = 0.f; float pv[16];
#pragma unroll
        for (int reg = 0; reg < 16; ++reg) { const float pe = ex2(sv[reg] - mrun); pv[reg] = pe; ps += pe; }
        lsum += ps;
        v4u pb0, pb1;
        pb0.x = pkbf(pv[0], pv[1]); pb0.y = pkbf(pv[2], pv[3]); pb0.z = pkbf(pv[4], pv[5]); pb0.w = pkbf(pv[6], pv[7]);
        pb1.x = pkbf(pv[8], pv[9]); pb1.y = pkbf(pv[10], pv[11]); pb1.z = pkbf(pv[12], pv[13]); pb1.w = pkbf(pv[14], pv[15]);
        LDS_WAIT();
#pragma unroll
        for (int s = 0; s < 2; ++s) {
            const bf16x8 pb = __builtin_bit_cast(bf16x8, s == 0 ? pb0 : pb1);
#pragma unroll
            for (int mt = 0; mt < 2; ++mt) {
                const unsigned r0 = (unsigned)(16 * s + 4 * hi + q4), ch = (unsigned)(4 * mt + 2 * blk + (p4 >> 1));
                const s16x4 lo = tr16(vt + vt_off(r0, ch) + 8 * (p4 & 1)), hi4 = tr16(vt + vt_off(r0 + 8, ch) + 8 * (p4 & 1));
                const bf16x8 va = {lo[0], lo[1], lo[2], lo[3], hi4[0], hi4[1], hi4[2], hi4[3]};
                if (mt == 0) o0 = __builtin_amdgcn_mfma_f32_32x32x16_bf16(va, pb, o0, 0, 0, 0);
                else o1 = __builtin_amdgcn_mfma_f32_32x32x16_bf16(va, pb, o1, 0, 0, 0);
            }
        }
        LDS_WAIT();
    }
    const float ltot = swap32_sum(lsum);
    if (STAGE < 2) {
        if (hi == 0) *mlp = (f32x2_t){mrun, ltot};
#pragma unroll
        for (int mt = 0; mt < 2; ++mt)
#pragma unroll
            for (int gq = 0; gq < 4; ++gq) { const f32x16& o = mt == 0 ? o0 : o1; u32x2 w; w.x = pkbf(o[4 * gq], o[4 * gq + 1]); w.y = pkbf(o[4 * gq + 2], o[4 * gq + 3]);
                *(LAS u32x2*)(oex + (((unsigned)(8 * mt + 2 * gq + hi) ^ fr) << 3)) = w; }
    } else {
        const float linv = 1.0f / ltot;
        bf16* op = MIX + ((size_t)b * T + tq) * KOUT + h * 64 + 4 * hi;
#pragma unroll
        for (int mt = 0; mt < 2; ++mt)
#pragma unroll
            for (int gq = 0; gq < 4; ++gq) { const f32x16& o = mt == 0 ? o0 : o1;
                u32x2 w; w.x = pkbf(o[4 * gq] * linv, o[4 * gq + 1] * linv); w.y = pkbf(o[4 * gq + 2] * linv, o[4 * gq + 3] * linv);
                *(GAS u32x2*)(op + 32 * mt + 8 * gq) = w; }
    }
}
__device__ __forceinline__ void unit(int b, int h, int rng, const bf16* QA, const bf16* KA, const bf16* VA, bf16* MIX, LAS unsigned char* lds, int lane, int wave) {
    const int T0 = rng * 512;
    LAS unsigned char* vt = lds + VT_OFF + wave * VT_BYTES;
    run_set<0>(b, h, T0, 2 * wave, QA, KA, VA, MIX, lds, vt, lane); run_set<0>(b, h, T0, 2 * wave + 1, QA, KA, VA, MIX, lds, vt, lane);
    __syncthreads();
    run_set<1>(b, h, T0, 2 * wave, QA, KA, VA, MIX, lds, vt, lane); run_set<1>(b, h, T0, 2 * wave + 1, QA, KA, VA, MIX, lds, vt, lane);
    __syncthreads();
    run_set<2>(b, h, T0, 2 * wave, QA, KA, VA, MIX, lds, vt, lane); run_set<2>(b, h, T0, 2 * wave + 1, QA, KA, VA, MIX, lds, vt, lane);
    __syncthreads();
}
}
#ifndef TKP
#define TKP 0
#endif
namespace tk {
constexpr int CAP = 632;
constexpr int WSCR = 3072;
__device__ __forceinline__ unsigned mono16(float sc) { const _Float16 hf = (_Float16)sc; const unsigned h = (unsigned)__builtin_bit_cast(unsigned short, hf); return (h ^ ((h & 0x8000u) ? 0xFFFFu : 0x8000u)) & 0xFFFFu; }
__device__ __forceinline__ float relu(float x) { const int b = __float_as_int(x); return __int_as_float(b > 0 ? b : 0); }
template <bool MASKED, int MT0, unsigned INCM>
__device__ __forceinline__ void tile_scores(const f32x16 (&X)[1], int key, int QT0, LAS unsigned* HIST, const LAS unsigned* EX, unsigned (&kout)[8], int hk) {
#pragma unroll
    for (int m2 = 0; m2 < 1; ++m2) { const int mt = MT0 + m2;
        asm volatile("" ::: "memory");
#pragma unroll
        for (int be = 0; be < 2; ++be) {
            const int qq = 4 * mt + 2 * hk + be;
            const LAS f32x4* wp = (const LAS f32x4*)(EX + 8 * qq);
            const f32x4 wa = wp[0], wb = wp[1];
            float sc = 0.f;
            sc = fmaf(wa[0], relu(X[m2][8 * be + 0]), sc); sc = fmaf(wa[1], relu(X[m2][8 * be + 1]), sc);
            sc = fmaf(wa[2], relu(X[m2][8 * be + 2]), sc); sc = fmaf(wa[3], relu(X[m2][8 * be + 3]), sc);
            sc = fmaf(wb[0], relu(X[m2][8 * be + 4]), sc); sc = fmaf(wb[1], relu(X[m2][8 * be + 5]), sc);
            sc = fmaf(wb[2], relu(X[m2][8 * be + 6]), sc); sc = fmaf(wb[3], relu(X[m2][8 * be + 7]), sc);
            const unsigned k16 = mono16(sc);
            kout[2 * mt + be] = k16;
            if (!MASKED || key <= QT0 + qq)
                __hip_atomic_fetch_add(HIST + qq * 2048 + ((k16 >> 4) & 2047u), ((k16 >> 15) ? 65536u : 1u) * INCM, __ATOMIC_RELAXED, __HIP_MEMORY_SCOPE_WORKGROUP);
        }
    }
}
__device__ __forceinline__ void store_keys(const unsigned (&kv)[8], int key, __amdgpu_buffer_rsrc_t scr, int hk) {
#pragma unroll
    for (int mt = 0; mt < 4; ++mt) __builtin_amdgcn_raw_buffer_store_b32(kv[2 * mt] | (kv[2 * mt + 1] << 16), scr, (key << 2) + (hk << 14), mt << 15, 0);
}
__device__ __forceinline__ unsigned prefix_scan(unsigned v) {
    v += (unsigned)__builtin_amdgcn_update_dpp(0, (int)v, 0x111, 0xf, 0xf, false);
    v += (unsigned)__builtin_amdgcn_update_dpp(0, (int)v, 0x112, 0xf, 0xf, false);
    v += (unsigned)__builtin_amdgcn_update_dpp(0, (int)v, 0x114, 0xf, 0xf, false);
    v += (unsigned)__builtin_amdgcn_update_dpp(0, (int)v, 0x118, 0xf, 0xf, false);
    v += (unsigned)__builtin_amdgcn_update_dpp(0, (int)v, 0x142, 0xa, 0xf, false);
    v += (unsigned)__builtin_amdgcn_update_dpp(0, (int)v, 0x143, 0xc, 0xf, false);
    return v;
}
__device__ __forceinline__ unsigned rdlane(unsigned v, int l) { return (unsigned)__builtin_amdgcn_readlane((int)v, l); }
__device__ __forceinline__ unsigned mbcnt64(unsigned long long m) { return __builtin_amdgcn_mbcnt_hi((unsigned)(m >> 32), __builtin_amdgcn_mbcnt_lo((unsigned)m, 0u)); }
__device__ __forceinline__ void zero_hist(LAS unsigned char* lds, int tid) {
    for (int e = tid; e < 16 * 2048 / 4; e += 512) ((LAS v4u*)lds)[e] = (v4u){0u, 0u, 0u, 0u};
}
template <unsigned INCM>
__device__ __forceinline__ void pass_a(const bf16* PROJ, size_t rowbase, int QT0, int nkt, LAS unsigned* HIST, const LAS unsigned* EX, __amdgpu_buffer_rsrc_t scr, const bf16x8 (&qf)[4][4], int kc, int hk, int wave) {
    {
        bf16x8 kn[4];
        if (wave < nkt) { const bf16* kp = PROJ + (rowbase + 32 * wave + kc) * NP2 + C_KI + 8 * hk;
#pragma unroll
            for (int s = 0; s < 4; ++s) kn[s] = *(const GAS bf16x8*)(kp + 16 * s); }
        unsigned pend[8]; int pkey = -1;
#pragma unroll
        for (int i = 0; i < 8; ++i) pend[i] = 0u;
        for (int kt = wave; kt < nkt; kt += NWAVES) {
            bf16x8 kf[4];
#pragma unroll
            for (int s = 0; s < 4; ++s) kf[s] = kn[s];
            if (kt + NWAVES < nkt) { const bf16* kp = PROJ + (rowbase + 32 * (kt + NWAVES) + kc) * NP2 + C_KI + 8 * hk;
#pragma unroll
                for (int s = 0; s < 4; ++s) kn[s] = *(const GAS bf16x8*)(kp + 16 * s); }
            if (pkey >= 0) store_keys(pend, pkey, scr, hk);
            const int key = 32 * kt + kc;
            const bool lastt = (kt == nkt - 1);
#pragma unroll
            for (int hf = 0; hf < 4; ++hf) {
                f32x16 X[1];
                X[0] = (f32x16){};
#pragma unroll
                for (int s = 0; s < 4; ++s) X[0] = __builtin_amdgcn_mfma_f32_32x32x16_bf16(qf[hf][s], kf[s], X[0], 0, 0, 0);
                if (hf == 0) { if (lastt) tile_scores<true, 0, INCM>(X, key, QT0, HIST, EX, pend, hk); else tile_scores<false, 0, INCM>(X, key, QT0, HIST, EX, pend, hk); }
                else if (hf == 1) { if (lastt) tile_scores<true, 1, INCM>(X, key, QT0, HIST, EX, pend, hk); else tile_scores<false, 1, INCM>(X, key, QT0, HIST, EX, pend, hk); }
                else if (hf == 2) { if (lastt) tile_scores<true, 2, INCM>(X, key, QT0, HIST, EX, pend, hk); else tile_scores<false, 2, INCM>(X, key, QT0, HIST, EX, pend, hk); }
                else { if (lastt) tile_scores<true, 3, INCM>(X, key, QT0, HIST, EX, pend, hk); else tile_scores<false, 3, INCM>(X, key, QT0, HIST, EX, pend, hk); }
            }
            pkey = key;
        }
        if (pkey >= 0) store_keys(pend, pkey, scr, hk);
    }
}
__device__ __forceinline__ void unit(int b, int qt, const bf16* PROJ, unsigned short* IDX, unsigned* SCw, LAS unsigned char* lds, LAS unsigned* EX, gu32* errw, int tid_in, int lane_in, int wave) {
    int tid = tid_in, lane = lane_in; asm volatile("" : "+v"(tid), "+v"(lane));
    const int QT0 = 16 * qt;
    const size_t rowbase = (size_t)b * T;
    if (QT0 < TOPK) {
        const int qq = tid >> 5, j0 = (tid & 31) * 8, t = QT0 + qq;
        unsigned short v[8];
#pragma unroll
        for (int j = 0; j < 8; ++j) v[j] = (j0 + j <= t) ? (unsigned short)(j0 + j) : (unsigned short)0xFFFF;
        v4u w; w.x = v[0] | ((unsigned)v[1] << 16); w.y = v[2] | ((unsigned)v[3] << 16); w.z = v[4] | ((unsigned)v[5] << 16); w.w = v[6] | ((unsigned)v[7] << 16);
        *(GAS v4u*)(IDX + (rowbase + t) * 256 + j0) = w;
        return;
    }
    LAS unsigned* HIST = (LAS unsigned*)lds;
    LAS unsigned short* SEL = (LAS unsigned short*)((LAS unsigned char*)EX + 1024 + wave * WSCR);
    LAS unsigned* CAND = (LAS unsigned*)((LAS unsigned char*)EX + 1024 + wave * WSCR + 528);
    const int nkt = (QT0 + 16 + 31) >> 5;
    const int kc = lane & 31, hk = lane >> 5;
    bf16x8 qf[4][4];
    { const int rho = lane & 31; const int ql = (rho >> 4) + 2 * ((rho >> 2) & 1), hd = 4 * ((rho >> 3) & 1) + (rho & 3);
#pragma unroll
      for (int mt = 0; mt < 4; ++mt) { const bf16* qp = PROJ + (rowbase + QT0 + 4 * mt + ql) * NP2 + C_QI + hd * 64 + 8 * hk;
#pragma unroll
          for (int s = 0; s < 4; ++s) qf[mt][s] = *(const GAS bf16x8*)(qp + 16 * s); } }
    if (tid < 128) { const int qq = tid >> 3, h = tid & 7; ((LAS float*)EX)[tid] = bf2f(PROJ[(rowbase + QT0 + qq) * NP2 + C_WI + h]) * IDX_SCALE; }
    __syncthreads();
    const __amdgpu_buffer_rsrc_t scr = __builtin_amdgcn_make_buffer_rsrc(SCw, 0, 8 * 4096 * 4, 0x00020000);
    if (TKP & 1) pass_a<0u>(PROJ, rowbase, QT0, nkt, HIST, EX, scr, qf, kc, hk, wave);
    pass_a<1u>(PROJ, rowbase, QT0, nkt, HIST, EX, scr, qf, kc, hk, wave);
    VM_WAIT();
    __syncthreads();
    asm volatile("" : "+v"(lane));
    v4u rowv[16];
    { const int tmax = QT0 + 2 * wave + 1;
#pragma unroll
      for (int c = 0; c < 16; ++c) { rowv[c] = (v4u){0u, 0u, 0u, 0u}; if (256 * c <= tmax) rowv[c] = __builtin_bit_cast(v4u, __builtin_amdgcn_raw_buffer_load_b128(scr, lane * 16, wave * 16384 + c * 1024, 0)); } }
#pragma unroll 1
    for (int qs2 = ((TKP & 2) ? 0 : 2); qs2 < 4; ++qs2) {
        const int qs = qs2 & 1; const bool zero_it = qs2 >= 2;
        const int qq = 2 * wave + qs, t = QT0 + qq;
        const int ksh = 16 * qs;
        LAS unsigned* Hq = HIST + qq * 2048;
        const int wl = 32 * (63 - lane);
        unsigned chi = 0, clo = 0;
        #pragma unroll 8
        for (int i = 0; i < 32; ++i) { const unsigned w = Hq[wl + ((i + lane) & 31)]; chi += w >> 16; clo += w & 0xFFFFu; }
        const unsigned Phi = prefix_scan(chi), Plo = prefix_scan(clo);
        const unsigned Ptot = rdlane(Phi, 63), Ntot = rdlane(Plo, 63);
        const bool half = Ptot >= (unsigned)TOPK;
        const unsigned base0 = half ? 0u : Ptot;
        const unsigned P = half ? Phi : Plo, tot = half ? chi : clo;
        const unsigned long long mk = __ballot(base0 + P >= (unsigned)TOPK);
        const int ls = mk ? (int)__builtin_ctzll(mk) : 0;
        const unsigned above = base0 + rdlane(P, ls) - rdlane(tot, ls);
        const int ws = 32 * (63 - ls);
        const unsigned w2 = Hq[ws + 31 - (lane & 31)];
        const unsigned v2 = lane < 32 ? (half ? (w2 >> 16) : (w2 & 0xFFFFu)) : 0u;
        const unsigned P2 = prefix_scan(v2);
        const unsigned long long mk2 = __ballot(above + P2 >= (unsigned)TOPK) & 0xFFFFFFFFull;
        const int j = mk2 ? (int)__builtin_ctzll(mk2) : 0;
        const unsigned na = above + rdlane(P2, j) - rdlane(v2, j);
        const unsigned bstar = ((half ? 1u : 0u) << 11) | (unsigned)(ws + 31 - j);
        if (lane == 0 && (mk == 0ull || mk2 == 0ull || Ptot + Ntot != (unsigned)(t + 1))) __hip_atomic_store(errw, 1u, RLX_AGENT);
        LDS_WAIT(); asm volatile("" ::: "memory");
        if (zero_it)
#pragma unroll
        for (int i = 0; i < 8; ++i) *(LAS v4u*)(Hq + 32 * lane + 4 * ((i + (lane >> 1)) & 7)) = (v4u){0u, 0u, 0u, 0u};
        unsigned short* irow = IDX + (rowbase + t) * 256;
        unsigned selbase = 0, candbase = 0;
        const unsigned thr_hi = (bstar + 1u) << 4, thr_lo = bstar << 4;
#pragma unroll
        for (int g = 0; g < 4; ++g) {
            if (1024 * g <= t) {
                unsigned k16v[16]; unsigned cnt = 0u, ccnt = 0u;
#pragma unroll
                for (int c = 0; c < 4; ++c)
#pragma unroll
                    for (int e = 0; e < 4; ++e) { const int key = 1024 * g + 256 * c + 4 * lane + e; unsigned k16 = (rowv[4 * g + c][e] >> ksh) & 0xFFFFu;
                        bool in = true; if (1024 * g + 1023 > t) in = key <= t;
                        k16v[4 * c + e] = k16; cnt += (in && k16 >= thr_hi) ? 1u : 0u; ccnt += (in && k16 >= thr_lo && k16 < thr_hi) ? 1u : 0u; }
                const bool tailg = 1024 * g + 1023 > t;
                { const unsigned Pc = prefix_scan(cnt); unsigned pos = selbase + Pc - cnt; selbase += rdlane(Pc, 63);
#pragma unroll
                  for (int i = 0; i < 16; ++i) { const int key = 1024 * g + 256 * (i >> 2) + 4 * lane + (i & 3); bool ab = k16v[i] >= thr_hi; if (tailg) ab = ab && key <= t;
                      SEL[ab ? (pos < 256u ? pos : 256u) : 256u] = (unsigned short)key; pos += ab ? 1u : 0u; } }
                if (__ballot(ccnt != 0u)) { const unsigned Pc = prefix_scan(ccnt); unsigned pos = candbase + Pc - ccnt; candbase += rdlane(Pc, 63);
#pragma unroll
                  for (int i = 0; i < 16; ++i) { const int key = 1024 * g + 256 * (i >> 2) + 4 * lane + (i & 3); bool cd = k16v[i] >= thr_lo && k16v[i] < thr_hi; if (tailg) cd = cd && key <= t;
                      if (cd) { if (pos < (unsigned)CAP) CAND[pos] = ((k16v[i] & 0xFu) << 12) | (unsigned)(4095 - key); ++pos; } } }
            }
        }
        const unsigned need = (unsigned)TOPK - na;
        unsigned nc = candbase;
        if (lane == 0 && (selbase != na || nc < need || nc > (unsigned)CAP)) __hip_atomic_store(errw, 2u, RLX_AGENT);
        nc = nc > (unsigned)CAP ? (unsigned)CAP : nc;
        LDS_WAIT(); asm volatile("" ::: "memory");
        if (lane < 4) CAND[nc + lane] = 0u;
        LDS_WAIT(); asm volatile("" ::: "memory");
        const int ns = (int)((nc + 63u) >> 6);
        unsigned cvs[10], rks[10];
#pragma unroll
        for (int sl = 0; sl < 10; ++sl) { cvs[sl] = 0xFFFFFFFFu; rks[sl] = 0u; if (sl < ns) { const unsigned i = lane + 64u * sl; if (i < nc) cvs[sl] = CAND[i]; } }
        for (unsigned jj = 0; jj < nc; jj += 4) { const v4u c4 = *(const LAS v4u*)(CAND + jj);
#pragma unroll
            for (int sl = 0; sl < 10; ++sl) if (sl < ns) rks[sl] += (c4.x > cvs[sl] ? 1u : 0u) + (c4.y > cvs[sl] ? 1u : 0u) + (c4.z > cvs[sl] ? 1u : 0u) + (c4.w > cvs[sl] ? 1u : 0u); }
#pragma unroll
        for (int sl = 0; sl < 10; ++sl) if (sl < ns) { const unsigned i = lane + 64u * sl; if (i < nc && rks[sl] < need) SEL[na + rks[sl]] = (unsigned short)(4095u - (cvs[sl] & 0xFFFu)); }
        LDS_WAIT(); asm volatile("" ::: "memory");
        if (lane < 32) { const v4u w = *(const LAS v4u*)(SEL + lane * 8); *(GAS v4u*)(irow + lane * 8) = w; }
        LDS_WAIT(); asm volatile("" ::: "memory");
    }
}
}
namespace sp {
constexpr int IMG_BYTES = 8192, IDXL_BYTES = 512, WAVE_BYTES = IMG_BYTES + IDXL_BYTES;
__device__ __forceinline__ unsigned off_b(unsigned row, unsigned ch) { return 256u * row + 16u * (ch ^ (((row & 3u) << 2) | ((row >> 2) & 3u))); }
__device__ __forceinline__ void query(int m  , const bf16* PROJ, const bf16* CKVN, const unsigned short* IDX, bf16* MIX, LAS unsigned char* wl, int lane) {
    LAS unsigned char* img = wl; LAS unsigned short* idl = (LAS unsigned short*)(wl + IMG_BYTES);
    const int b = m >> 12, t = m & 4095;
    const int hd = lane & 15, g = lane >> 4;
    const bf16* cb = CKVN + (size_t)b * T * 128;
    { const u32x2 w = *(const GAS u32x2*)(IDX + (size_t)m * 256 + 4 * lane); *(LAS u32x2*)(idl + 4 * lane) = w; }
    bf16x8 qf[4];
#pragma unroll
    for (int s = 0; s < 4; ++s) { bf16x8 z = {}; qf[s] = hd < 8 ? *(const GAS bf16x8*)(PROJ + (size_t)m * NP2 + C_QL + hd * 128 + 32 * s + 8 * g) : z; }
    const float slope = exp2f(-(float)((hd & 7) + 1));
    const float sl2 = slope * LOG2E, c2 = 0.125f * LOG2E;
    float mrun = -1e30f, lsum = 0.f;
    f32x4 o[8];
#pragma unroll
    for (int i = 0; i < 8; ++i) o[i] = (f32x4){0.f, 0.f, 0.f, 0.f};
    LDS_WAIT();
    const int q4 = (lane & 15) >> 2, p4 = lane & 3;
    bf16x8 gn[8];
#pragma unroll
    for (int i = 0; i < 8; ++i) { const int n = lane + 64 * i, row = n >> 4, ch = n & 15; unsigned id = idl[row]; id = id == 0xFFFFu ? 0u : id; gn[i] = *(const GAS bf16x8*)(cb + (size_t)id * 128 + ch * 8); }
    for (int c = 0; c < 8; ++c) {
#pragma unroll
        for (int i = 0; i < 8; ++i) { const int n = lane + 64 * i, row = n >> 4, ch = n & 15; *(LAS bf16x8*)(img + off_b(row, ch)) = gn[i]; }
        if (c + 1 < 8) {
#pragma unroll
            for (int i = 0; i < 8; ++i) { const int n = lane + 64 * i, row = n >> 4, ch = n & 15; unsigned id = idl[32 * (c + 1) + row]; id = id == 0xFFFFu ? 0u : id; gn[i] = *(const GAS bf16x8*)(cb + (size_t)id * 128 + ch * 8); }
        }
        LDS_WAIT();
        float sv[8]; float mx = -1e30f;
#pragma unroll
        for (int rb = 0; rb < 2; ++rb) {
            f32x4 acc = {0.f, 0.f, 0.f, 0.f};
#pragma unroll
            for (int s = 0; s < 4; ++s) { const bf16x8 a = *(const LAS bf16x8*)(img + off_b((lane & 15) + 16 * rb, 4 * s + g)); acc = __builtin_amdgcn_mfma_f32_16x16x32_bf16(a, qf[s], acc, 0, 0, 0); }
            const u32x2 iw = *(const LAS u32x2*)(idl + 32 * c + 16 * rb + 4 * g);
            const unsigned ids[4] = {iw.x & 0xFFFFu, iw.x >> 16, iw.y & 0xFFFFu, iw.y >> 16};
#pragma unroll
            for (int e = 0; e < 4; ++e) { const bool ok = ids[e] != 0xFFFFu; const float v = ok ? (acc[e] * c2 - sl2 * (float)(t - (int)ids[e])) : -1e30f; sv[4 * rb + e] = v; mx = fmaxf(mx, v); }
        }
        mx = fmaxf(mx, __shfl_xor(mx, 16)); mx = fmaxf(mx, __shfl_xor(mx, 32));
        const float mnew = fmaxf(mrun, mx);
        const float alpha = ex2(mrun - mnew);
        mrun = mnew;
        float pv[8]; float ps = 0.f;
#pragma unroll
        for (int e = 0; e < 8; ++e) { const float pe = (sv[e] > -1e29f) ? ex2(sv[e] - mnew) : 0.f; pv[e] = pe; ps += pe; }
        lsum = lsum * alpha + ps;
        v4u pw; pw.x = pkbf(pv[0], pv[1]); pw.y = pkbf(pv[2], pv[3]); pw.z = pkbf(pv[4], pv[5]); pw.w = pkbf(pv[6], pv[7]);
        const bf16x8 pb = __builtin_bit_cast(bf16x8, pw);
#pragma unroll
        for (int mt = 0; mt < 8; ++mt) {
            const s16x4 lo = tr16(img + off_b(4 * g + q4, 2 * mt + (p4 >> 1)) + 8 * (p4 & 1));
            const s16x4 hi4 = tr16(img + off_b(16 + 4 * g + q4, 2 * mt + (p4 >> 1)) + 8 * (p4 & 1));
            const bf16x8 a = {lo[0], lo[1], lo[2], lo[3], hi4[0], hi4[1], hi4[2], hi4[3]};
            o[mt] = o[mt] * alpha;
            o[mt] = __builtin_amdgcn_mfma_f32_16x16x32_bf16(a, pb, o[mt], 0, 0, 0);
        }
        LDS_WAIT();
    }
    lsum += __shfl_xor(lsum, 16); lsum += __shfl_xor(lsum, 32);
    const float linv = 1.0f / lsum;
    if (hd < 8) {
        bf16* op = MIX + (size_t)m * KOUT + 512 + hd * 128 + 4 * g;
#pragma unroll
        for (int mt = 0; mt < 8; ++mt) { u32x2 w; w.x = pkbf(o[mt][0] * linv, o[mt][1] * linv); w.y = pkbf(o[mt][2] * linv, o[mt][3] * linv); *(GAS u32x2*)(op + 16 * mt) = w; }
    }
}
}
#ifndef DUP_MASK
#define DUP_MASK 0
#endif
struct Args { const float* in[14]; float* out; unsigned char* ws; int ph_lo, ph_hi; };
__global__ void __launch_bounds__(NWAVES * 64, 2) fwd(Args args) {
    extern __shared__ __attribute__((aligned(16))) unsigned char lds[];
    Frame F;
    F.lds = (LAS unsigned char*)lds;
    F.MISC = (volatile LAS unsigned*)(F.lds + MISC_OFF);
    F.tid = threadIdx.x; F.lane = F.tid & 63; F.wave = __builtin_amdgcn_readfirstlane(F.tid >> 6);
    F.G = gridDim.x;
    unsigned char* ws = args.ws;
    F.ctl = (gu32*)(ws + WS_CTL);
    F.x = args.in[0]; F.c = args.in[1]; F.w_ada = args.in[2]; F.b_ada = args.in[3]; F.g_attn = args.in[4]; F.w_in = args.in[5]; F.kv_g = args.in[6];
    F.w_uk = args.in[7]; F.w_uv = args.in[8]; F.w_out = args.in[9]; F.g_ffn = args.in[10]; F.w_gu = args.in[11]; F.w_down = args.in[12]; F.g_final = args.in[13];
    F.out = args.out;
    F.MOD = (float*)(ws + WS_MOD);
    F.WIN = (bf16*)(ws + WS_WIN); F.WOUT = (bf16*)(ws + WS_WOUT); F.WGU = (bf16*)(ws + WS_WGU); F.WDN = (bf16*)(ws + WS_WDN);
    F.CKVN = (bf16*)(ws + WS_CKVN); F.IDX = (unsigned short*)(ws + WS_IDX); F.XN = (bf16*)(ws + WS_XN); F.MIX = (bf16*)(ws + WS_MIX); F.PROJ = (bf16*)(ws + WS_PROJ); F.HB = (bf16*)(ws + WS_H); F.QKVA = (bf16*)(ws + WS_QKVA);
    for (int u = F.tid; u < (LDS_BYTES - LDSCTL_OFF) / 4; u += NWAVES * 64) ((LAS unsigned*)(F.lds + LDSCTL_OFF))[u] = 0u;
    __syncthreads();
    XcdBarrier bar = xcd_barrier_post((unsigned*)(F.ctl + CW_BAR), F.MISC + 8);
    const int lo = args.ph_lo, hi = args.ph_hi;
#define IN(k) (lo <= (k) && (k) < hi)
#define BOTH(k) (IN(k) && IN((k) + 1))
#define GRID_BAR() xcd_barrier(bar)

    if (IN(0)) { p0_prologue(F); if (BOTH(0)) GRID_BAR(); }
    if (IN(1)) { modnorm_rows(F, F.x, F.g_attn, 1, 0, F.XN); if (BOTH(1)) GRID_BAR(); }
    if (IN(2)) {
        pg8::Gemm g{F.XN, F.WIN, M, NPROJ, D}; pg8::StaticOrder S; S.init(M, NPROJ, F.G, (int)blockIdx.x);
        pg8::EpiProj E{F.QKVA, F.PROJ, NP2};
        pg8::gemm_phase<pg8::EpiProj, pg8::StaticOrder, true, true>(F.lds + RING_OFF, g, S, E);
        if (BOTH(2)) GRID_BAR();
    }
    if (IN(3)) {
        { int t_ = threadIdx.x; asm volatile("" : "+v"(t_)); F.tid = t_; F.lane = t_ & 63; }
        ckv_norm_rows(F);
        for (int rep = 0; rep < ((DUP_MASK & 1) ? 2 : 1); ++rep)
        for (int rd = 0; rd * F.G < 512; ++rd) { const int L = rd * F.G + (int)blockIdx.x; if (L < 512) { int pair, rng;
            if ((F.G & 7) == 0) { const int xcd = (int)blockIdx.x & 7, j = rd * (F.G >> 3) + ((int)blockIdx.x >> 3); pair = xcd * 8 + (j >> 3); rng = j & 7; } else { pair = L >> 3; rng = L & 7; }
            if (pair < 64) ga::unit(pair >> 3, pair & 7, rng, F.QKVA, F.QKVA + (size_t)M * 512, F.QKVA + (size_t)2 * M * 512, F.MIX, F.lds + RING_OFF, F.lane, F.wave); } }
        __syncthreads();
        tk::zero_hist(F.lds + RING_OFF, F.tid);
        for (int rep = 0; rep < ((DUP_MASK & 2) ? 2 : 1); ++rep)
        for (int i = 0; i * F.G < 2048; ++i) { const int gp = (i & 1) ? (F.G - 1 - (int)blockIdx.x) : (int)blockIdx.x; const int L = i * F.G + gp;
            if (L < 2048) tk::unit(L & 7, L >> 3, F.PROJ, F.IDX, (unsigned*)F.XN + (size_t)blockIdx.x * 32768, F.lds + RING_OFF, (LAS unsigned*)(F.lds + EX_OFF), F.ctl + CW_ERR, F.tid, F.lane, F.wave); }
        if (BOTH(3)) GRID_BAR();
    }
    if (IN(4)) {
        { int t_ = threadIdx.x; asm volatile("" : "+v"(t_)); F.tid = t_; F.lane = t_ & 63; }
        const int gw = blockIdx.x * NWAVES + F.wave, NGW = F.G * NWAVES;
        for (int rep = 0; rep < ((DUP_MASK & 4) ? 2 : 1); ++rep)
        for (int m = gw; m < M; m += NGW) sp::query(m, F.PROJ, F.CKVN, F.IDX, F.MIX, F.lds + RING_OFF + F.wave * sp::WAVE_BYTES, F.lane);
        if (BOTH(4)) GRID_BAR();
    }
    if (IN(5)) {
        pg8::Gemm g{F.MIX, F.WOUT, M, D, KOUT}; pg8::StaticOrder S; S.init(M, D, F.G, (int)blockIdx.x);
        pg8::EpiGateRes E{F.x, F.out, D, F.MOD + 2 * 1024, 6144};
        pg8::gemm_phase<pg8::EpiGateRes, pg8::StaticOrder, true, true>(F.lds + RING_OFF, g, S, E);
        if (BOTH(5)) GRID_BAR();
    }
    if (IN(6)) { if (FFN_FP8) modnorm_rows8(F, F.out, F.g_ffn, 4, 3, (unsigned char*)F.XN, X8_SCALE); else modnorm_rows(F, F.out, F.g_ffn, 4, 3, F.XN); if (BOTH(6)) GRID_BAR(); }
    if (IN(7)) {
        if (FFN_FP8) {
            pg8::Gemm g{F.XN, F.WGU, M, NGU, D / 2, E8_W, E8_X}; pg8::StaticOrder S; S.init(M, NGU, F.G, (int)blockIdx.x);
            pg8::EpiSwiGLU8 E{(unsigned char*)F.HB, DFF, H8_SCALE};
            pg8::gemm_phase<pg8::EpiSwiGLU8, pg8::StaticOrder, true, true, true>(F.lds + RING_OFF, g, S, E);
        } else {
            pg8::Gemm g{F.XN, F.WGU, M, NGU, D}; pg8::StaticOrder S; S.init(M, NGU, F.G, (int)blockIdx.x);
            pg8::EpiSwiGLU E{F.HB, DFF};
            pg8::gemm_phase<pg8::EpiSwiGLU, pg8::StaticOrder, true, true>(F.lds + RING_OFF, g, S, E);
        }
        if (BOTH(7)) GRID_BAR();
    }
    if (IN(8)) {
        pg8::StaticOrder S; S.init(M, D, F.G, (int)blockIdx.x);
        pg8::EpiGateRes E{F.out, F.out, D, F.MOD + 5 * 1024, 6144};
        if (FFN_FP8) { pg8::Gemm g{F.HB, F.WDN, M, D, DFF / 2, E8_W, E8_H}; pg8::gemm_phase<pg8::EpiGateRes, pg8::StaticOrder, true, true, true>(F.lds + RING_OFF, g, S, E); }
        else { pg8::Gemm g{F.HB, F.WDN, M, D, DFF}; pg8::gemm_phase<pg8::EpiGateRes, pg8::StaticOrder, true, true>(F.lds + RING_OFF, g, S, E); }
        if (BOTH(8)) GRID_BAR();
    }
    if (IN(9)) {
        final_norm_rows(F);
        const unsigned bad = __hip_atomic_load(F.ctl + CW_ERR, RLX_AGENT) | __hip_atomic_load((gu32*)((unsigned*)(F.ctl + CW_BAR) + XB_TMO), RLX_AGENT);
        if (bad != 0u && blockIdx.x == 0 && F.tid < 64) F.out[F.tid] = __builtin_nanf("");
    }
#undef IN
#undef BOTH
#undef GRID_BAR
}

#ifndef MK_N_LAUNCHES
#define MK_N_LAUNCHES 1
#endif
extern "C" void kernel_launch(void* const* d_in, const int* in_sizes, int n_in, void* d_out, int out_size, void* d_ws, size_t ws_size, hipStream_t stream) {
    static int grid = 0;
    if (grid == 0) {
        if (n_in != 14 || in_sizes[0] != M * D || out_size != M * D || ws_size < WS_END) { fprintf(stderr, "kernel_launch: unexpected shapes: n_in %d in0 %d out %d ws %zu (need %zu)\n", n_in, n_in > 0 ? in_sizes[0] : -1, out_size, ws_size, (size_t)WS_END); grid = -1; return; }
        int dev = 0, cus = 0, per_cu = 0;
        if (hipGetDevice(&dev) != hipSuccess || hipDeviceGetAttribute(&cus, hipDeviceAttributeMultiprocessorCount, dev) != hipSuccess) { grid = -1; return; }
        if (hipFuncSetAttribute((const void*)fwd, hipFuncAttributeMaxDynamicSharedMemorySize, LDS_BYTES) != hipSuccess) { fprintf(stderr, "kernel_launch: hipFuncSetAttribute failed\n"); grid = -1; return; }
        if (hipOccupancyMaxActiveBlocksPerMultiprocessor(&per_cu, (const void*)fwd, NWAVES * 64, LDS_BYTES) != hipSuccess || per_cu < 1) fprintf(stderr, "kernel_launch: occupancy query reports %d\n", per_cu);
        (void)hipGetLastError();
        grid = cus;
    }
    if (grid < 0) return;
    if (hipMemsetAsync((char*)d_ws + WS_CTL, 0, CTL_ZERO_BYTES, stream) != hipSuccess) return;
    Args a{};
    for (int i = 0; i < 14; ++i) a.in[i] = (const float*)d_in[i];
    a.out = (float*)d_out; a.ws = (unsigned char*)d_ws;
#if MK_N_LAUNCHES == 1
    a.ph_lo = 0; a.ph_hi = 10;
    hipLaunchKernelGGL(fwd, dim3(grid), dim3(NWAVES * 64), LDS_BYTES, stream, a);
#else
    for (int p = 0; p < 10; ++p) { a.ph_lo = p; a.ph_hi = p + 1; hipLaunchKernelGGL(fwd, dim3(grid), dim3(NWAVES * 64), LDS_BYTES, stream, a); }
#endif
}
```
